# Optimizing an MI355X kernel written in HIP

```python
import jax, jax.numpy as jnp
from jax import lax
import numpy as np

D_MODEL = 1024
BATCH = 2
SEQ = 16384
DEPTH = 4

HG_HEADS = 8
HG_DK = 128
HG_DV = 128
HG_WIDTH = HG_HEADS * HG_DK
HG_CHUNK = 64
ATT_Q_HEADS = 16
ATT_KV_HEADS = 4
ATT_GROUP = ATT_Q_HEADS // ATT_KV_HEADS
ATT_HEAD_DIM = 64
ATT_WIDTH = ATT_Q_HEADS * ATT_HEAD_DIM
ATT_KV_WIDTH = ATT_KV_HEADS * ATT_HEAD_DIM
WINDOW = 128
ATT_BLOCK = 128
ROPE_THETA = 500000.0
ROPE_DIM = ATT_HEAD_DIM // 4
FFN_HIDDEN = ((8 * D_MODEL // 3 + 255) // 256) * 256
EPS = 1e-6
MIN_F = 1e-30
IN_SIZES = (HG_WIDTH, HG_WIDTH, HG_WIDTH, HG_WIDTH, ATT_WIDTH, ATT_KV_WIDTH, ATT_KV_WIDTH, D_MODEL, D_MODEL)
IN_COLS = 4 * HG_WIDTH + ATT_WIDTH + 2 * ATT_KV_WIDTH + 2 * D_MODEL

kernel_name = "hgrn2_swa_sink_gated_hybrid"


def rmsnorm(x, g):
    xf = x.astype(jnp.float32)
    y = xf * lax.rsqrt(jnp.mean(xf * xf, axis=-1, keepdims=True) + EPS)
    return (y * g.astype(jnp.float32)).astype(x.dtype)


def split_cols(proj):
    points, acc = [], 0
    for s in IN_SIZES[:-1]:
        acc += s
        points.append(acc)
    return jnp.split(proj, points, axis=-1)


def rope_partial(x, pos):
    half = ROPE_DIM // 2
    inv = ROPE_THETA ** (-jnp.arange(half, dtype=jnp.float32) * 2.0 / ROPE_DIM)
    ang = pos.astype(jnp.float32)[:, None] * inv[None, :]
    cos = jnp.cos(ang)[None, :, None, :]
    sin = jnp.sin(ang)[None, :, None, :]
    xr = x[..., :ROPE_DIM].astype(jnp.float32)
    x1, x2 = xr[..., :half], xr[..., half:]
    rot = jnp.concatenate([x1 * cos - x2 * sin, x2 * cos + x1 * sin], axis=-1)
    return jnp.concatenate([rot.astype(x.dtype), x[..., ROPE_DIM:]], axis=-1)


def hgrn2_chunked(q, k, v, logf):
    B, S, H, DK = q.shape
    DV = v.shape[-1]
    C = HG_CHUNK
    n = S // C

    def to_chunks(t):
        return t.reshape(B, n, C, H, t.shape[-1]).transpose(1, 0, 3, 2, 4)

    qc, kc, vc, fc = to_chunks(q), to_chunks(k), to_chunks(v), to_chunks(logf)
    causal = jnp.tril(jnp.ones((C, C), dtype=bool))

    def step(state, inp):
        qi, ki, vi, fi = inp
        b = jnp.cumsum(fi, axis=2)
        o_inter = jnp.einsum('bhtk,bhkv->bhtv', qi * jnp.exp(b), state)
        diff = b[:, :, :, None, :] - b[:, :, None, :, :]
        decay = jnp.exp(jnp.where(causal[:, :, None], diff, -jnp.inf))
        scores = jnp.einsum('bhtk,bhsk,bhtsk->bhts', qi, ki, decay)
        o_intra = jnp.einsum('bhts,bhsv->bhtv', scores, vi)
        b_last = b[:, :, -1:, :]
        new_state = jnp.exp(b_last[:, :, 0, :])[..., None] * state + jnp.einsum(
            'bhsk,bhsv->bhkv', ki * jnp.exp(b_last - b), vi)
        return new_state, o_inter + o_intra

    init = jnp.zeros((B, H, DK, DV), jnp.float32)
    _, o = lax.scan(step, init, (qc, kc, vc, fc))
    return o.transpose(1, 0, 3, 2, 4).reshape(B, S, H, DV)


def swa_with_sinks(q, k, v, sinks):
    B, S, Hq, hd = q.shape
    W = ATT_BLOCK
    n = S // W
    qb = q.reshape(B, n, W, ATT_KV_HEADS, ATT_GROUP, hd)

    def with_prev(t):
        tb = t.reshape(B, n, W, ATT_KV_HEADS, hd)
        prev = jnp.pad(tb, ((0, 0), (1, 0), (0, 0), (0, 0), (0, 0)))[:, :-1]
        return jnp.concatenate([prev, tb], axis=2)

    kw, vw = with_prev(k), with_prev(v)
    s = jnp.einsum('bnqhgd,bnshd->bnhgqs', qb, kw).astype(jnp.float32) * (hd ** -0.5)
    blk = jnp.arange(n)[:, None, None] * W
    qpos = blk + jnp.arange(W)[None, :, None]
    kpos = blk - W + jnp.arange(2 * W)[None, None, :]
    delta = qpos - kpos
    mask = (delta >= 0) & (delta < WINDOW) & (kpos >= 0)
    s = jnp.where(mask[None, :, None, None], s, -jnp.inf)
    sink = sinks.astype(jnp.float32).reshape(1, 1, ATT_KV_HEADS, ATT_GROUP, 1, 1)
    m = jnp.maximum(jnp.max(s, axis=-1, keepdims=True), sink)
    p = jnp.exp(s - m)
    p = p / (jnp.sum(p, axis=-1, keepdims=True) + jnp.exp(sink - m))
    o = jnp.einsum('bnhgqs,bnshd->bnqhgd', p.astype(v.dtype), vw)
    return o.reshape(B, S, Hq * hd)


def setup_inputs(seed: int = 0) -> dict:
    key = jax.random.key(seed)
    ks = jax.random.split(key, 16)
    f32 = jnp.float32
    nrm = lambda k, shape, scale: jax.random.normal(k, shape, f32) * scale
    return {
        "x": nrm(ks[0], (BATCH, SEQ, D_MODEL), 1.0),
        "norm1": 1.0 + nrm(ks[1], (DEPTH, D_MODEL), 0.01),
        "w_in": nrm(ks[2], (DEPTH, D_MODEL, IN_COLS), D_MODEL ** -0.5),
        "lb_logits": nrm(ks[3], (DEPTH, HG_WIDTH), 0.5),
        "hg_norm": 1.0 + nrm(ks[4], (DEPTH, HG_WIDTH), 0.01),
        "attn_sinks": nrm(ks[5], (DEPTH, ATT_Q_HEADS), 0.5),
        "w_pa": nrm(ks[6], (DEPTH, HG_WIDTH, D_MODEL), HG_WIDTH ** -0.5),
        "w_pb": nrm(ks[7], (DEPTH, ATT_WIDTH, D_MODEL), ATT_WIDTH ** -0.5),
        "w_o": nrm(ks[8], (DEPTH, D_MODEL, D_MODEL), D_MODEL ** -0.5),
        "norm2": 1.0 + nrm(ks[9], (DEPTH, D_MODEL), 0.01),
        "w_gate": nrm(ks[10], (DEPTH, D_MODEL, FFN_HIDDEN), D_MODEL ** -0.5),
        "w_up": nrm(ks[11], (DEPTH, D_MODEL, FFN_HIDDEN), D_MODEL ** -0.5),
        "w_down": nrm(ks[12], (DEPTH, FFN_HIDDEN, D_MODEL), FFN_HIDDEN ** -0.5),
        "final_norm": 1.0 + nrm(ks[13], (D_MODEL,), 0.01),
    }


def reference(x, norm1, w_in, lb_logits, hg_norm, attn_sinks, w_pa, w_pb, w_o,
              norm2, w_gate, w_up, w_down, final_norm):
    B, S, _ = x.shape
    pos = jnp.arange(S)
    lb_p = jax.nn.softmax(lb_logits.astype(jnp.float32), axis=0)
    lb_all = jnp.cumsum(lb_p, axis=0) - lb_p[0:1]

    for l in range(DEPTH):
        h = rmsnorm(x, norm1[l])
        proj = h @ w_in[l]
        hq, hf, hi, hg, aq, ak, av, ga, gb = split_cols(proj)

        q = jax.nn.silu(hq).reshape(B, S, HG_HEADS, HG_DK).astype(jnp.float32)
        z = hf.reshape(B, S, HG_HEADS, HG_DK).astype(jnp.float32)
        lb = lb_all[l].reshape(HG_HEADS, HG_DK)
        f = lb + (1.0 - lb) * jax.nn.sigmoid(z)
        logf = jnp.log(jnp.maximum(f, MIN_F))
        kk = 1.0 - f
        vi = hi.reshape(B, S, HG_HEADS, HG_DV).astype(jnp.float32)
        o_hg = hgrn2_chunked(q, kk, vi, logf)
        o_hg = rmsnorm(o_hg, hg_norm[l].reshape(HG_HEADS, HG_DV)).astype(x.dtype)
        o_hg = o_hg.reshape(B, S, HG_WIDTH) * jax.nn.silu(hg)
        y_a = o_hg @ w_pa[l]

        qa = rope_partial(aq.reshape(B, S, ATT_Q_HEADS, ATT_HEAD_DIM), pos)
        ka = rope_partial(ak.reshape(B, S, ATT_KV_HEADS, ATT_HEAD_DIM), pos)
        va = av.reshape(B, S, ATT_KV_HEADS, ATT_HEAD_DIM)
        y_b = swa_with_sinks(qa, ka, va, attn_sinks[l]) @ w_pb[l]

        mix = jax.nn.sigmoid(ga) * y_a + jax.nn.sigmoid(gb) * y_b
        x = x + mix @ w_o[l]

        h2 = rmsnorm(x, norm2[l])
        x = x + (jax.nn.silu(h2 @ w_gate[l]) * (h2 @ w_up[l])) @ w_down[l]

    return rmsnorm(x, final_norm)
```

```cpp
#include <hip/hip_runtime.h>
#include <hip/hip_cooperative_groups.h>
#include <cstdio>
#include <cstdint>
namespace cg = cooperative_groups;

#define LAS __attribute__((address_space(3)))
typedef unsigned short bf16_t;
typedef short bf16x8 __attribute__((ext_vector_type(8)));
typedef short s16x4 __attribute__((ext_vector_type(4)));
typedef float f32x2 __attribute__((ext_vector_type(2)));
typedef float f32x4 __attribute__((ext_vector_type(4)));
typedef float f32x16 __attribute__((ext_vector_type(16)));
typedef unsigned u32x2 __attribute__((ext_vector_type(2)));
typedef unsigned u32x4 __attribute__((ext_vector_type(4)));
typedef __bf16 bf16x2_t __attribute__((ext_vector_type(2)));

constexpr int BATCH = 2, SEQ = 16384, T = BATCH * SEQ, D = 1024, DEPTH = 4;
constexpr int NIN = 7680, NIN1 = 5632, FF = 2816, NGU = 2 * FF;
constexpr int HGH = 8;
constexpr int SC_TOK = 1024, NSC = SEQ / SC_TOK, CH = 64, NCH = SC_TOK / CH;
constexpr float EPS = 1e-6f;
constexpr int QP = 2176;
constexpr int NWAVES = 8, NTHR = 512;

constexpr size_t MiB = 1u << 20;
constexpr size_t WS_LB = 1280 * 1024;
constexpr size_t WS_HD = 1536 * 1024;
constexpr size_t WS_ROPE = 2 * MiB;
constexpr size_t WS_WIN = 3 * MiB, WS_WPA = 18 * MiB, WS_WPB = 20 * MiB, WS_WO = 22 * MiB, WS_WGU = 24 * MiB, WS_WD = 35 * MiB;
constexpr size_t WS_XB = 41 * MiB;
constexpr size_t WS_QA = 105 * MiB;
constexpr size_t WS_LOGF = 241 * MiB;
constexpr size_t WS_V = 305 * MiB;
constexpr size_t WS_GH = 369 * MiB;
constexpr size_t WS_AK = 433 * MiB, WS_AV = 449 * MiB;
constexpr size_t WS_ST = 465 * MiB;
constexpr size_t WS_SSP = 481 * MiB;
constexpr size_t WS_WPAB = 500 * MiB;
constexpr size_t WS_END = 505 * MiB;
constexpr int LDS_RS = 131072;
constexpr size_t WS_GATE = WS_V, WS_MIX = WS_GH, WS_ACT = WS_QA;
static_assert(WS_ACT + (size_t)T * FF * 2 <= WS_V && WS_QA + (size_t)T * QP * 2 <= WS_LOGF && WS_WPAB + (size_t)D * QP * 2 <= WS_END, "workspace map");

constexpr int LDS_BYTES = 147456 + 256;
constexpr int LDS_XB = 147456;
constexpr size_t WS_BAR = 1792 * 1024;

__device__ __forceinline__ int fresh_tid() { int t = threadIdx.x; asm volatile("" : "+v"(t)); return t; }
namespace pg8 {
constexpr int BM = 256, BK = 64, HALF = 128, HTB = HALF * BK * 2, STAGE_BYTES = 8 * HTB, NXCD = 8, WGM = 4;
__host__ __device__ __forceinline__ int lds_byte(int r, int c) { const int st = (r >> 4) * 2 + (c >> 5), rr = r & 15, cc = c & 31, ob = rr * 64 + cc * 2; return st * 1024 + (ob ^ (((ob >> 9) & 1) << 5)); }
__host__ __device__ __forceinline__ void stage_rc(int b, int& R, int& C) { const int st = b / 1024, sb = b % 1024, swz = sb ^ (((sb >> 9) & 1) << 5); R = (st >> 1) * 16 + swz / 64; C = (st & 1) * 32 + (swz % 64) / 2; }
__host__ __device__ __forceinline__ int perm32(int rho) { const int n = rho >> 4, i = rho & 15; return 8 * (i >> 2) + 4 * n + (i & 3); }
__device__ __forceinline__ void glds16s(const void* sbase, unsigned voff, unsigned lds_dst) {
    unsigned keep;
    asm volatile("s_mov_b32 %0, m0\n\ts_mov_b32 m0, %3\n\ts_nop 0\n\tglobal_load_lds_dwordx4 %1, %2\n\ts_mov_b32 m0, %0" : "=&s"(keep) : "v"(voff), "s"(sbase), "s"(lds_dst) : "memory");
}
struct Unit { int pm, pn, idx; };
struct Gemm { const bf16_t* A; const bf16_t* Bt; int M, N, K, lda; int ldb = 0; };
struct StaticOrder {
    int nM, nN, nwg, G, c; bool PAIR = false;
    __host__ __device__ void init(int M, int N, int G_, int c_) { nM = M / BM; nN = N / BM; nwg = nM * nN; G = G_; c = c_; }
    __host__ __device__ bool next(int i, Unit& u) const {
        if (PAIR) { if (!next1(i >> 1, u)) return false; u.pn += (i & 1) * nN; return true; }
        return next1(i, u);
    }
    __host__ __device__ bool next1(int i, Unit& u) const {
        const long L = (long)i * G + c; if (L >= nwg) return false;
        int wgid = (int)L; { const int q = nwg / NXCD, r = nwg % NXCD, xcd = wgid % NXCD, off = wgid / NXCD; wgid = (xcd < r ? xcd * (q + 1) : r * (q + 1) + (xcd - r) * q) + off; }
        const int nig = WGM * nN, gid = wgid / nig, fm = gid * WGM, gsz = (nM - fm) < WGM ? (nM - fm) : WGM;
        u.pm = fm + ((wgid % nig) % gsz); u.pn = (wgid % nig) / gsz; u.idx = i; return true;
    }
};
template <class Epi, bool ALIGN_EPI = true>
__device__ __forceinline__ void gemm_phase(LAS unsigned char* lds, const Gemm g, const StaticOrder& S, const Epi& E) {
    const int tid = fresh_tid(), wid = __builtin_amdgcn_readfirstlane(tid >> 6), lane = tid & 63, wr = wid >> 2, wc = wid & 3, fr = lane & 15, fq = lane >> 4;
    const int K = g.K, nt = K / BK, lda = g.lda, ldb = g.ldb ? g.ldb : g.K;
    unsigned voffA[2], voffB[2];
#pragma unroll
    for (int i = 0; i < 2; ++i) { int R, C; stage_rc(tid * 16 + i * 8192, R, C); const int Rb = (R & ~31) + perm32(R & 31);
        voffA[i] = (unsigned)(R * lda + C) * 2u; voffB[i] = (unsigned)(Rb * ldb + C) * 2u; }
    const size_t kstep = (size_t)(BK * 2);
    const size_t hstepA = (size_t)HALF * lda * 2, hstepB = (size_t)HALF * ldb * 2;
    const size_t tstepA = 2 * hstepA, tstepB = 2 * hstepB;
    const unsigned ldsw = (unsigned)wid * 1024u, ldsb = (unsigned)(size_t)lds;
    const int aoff = lds_byte(wr * 64 + fr, fq * 8), boff = lds_byte(wc * 32 + fr, fq * 8);
#define PG8_SA(b, h) (((b) * 2 + (h)) * HTB)
#define PG8_SB(b, h) ((4 + (b) * 2 + (h)) * HTB)
#define PG8_STAGE(bufoff, gbase, voff) do { _Pragma("unroll") for (int _i = 0; _i < 2; ++_i) \
        glds16s((const void*)(gbase), (voff)[_i], ldsb + (unsigned)(bufoff) + ldsw + (unsigned)(_i * 8192)); } while (0)
#define PG8_LDA(dst, b, h) do { _Pragma("unroll") for (int m = 0; m < 4; ++m) _Pragma("unroll") for (int k = 0; k < 2; ++k) dst[m][k] = *(const LAS bf16x8*)(lds + PG8_SA(b, h) + aoff + m * 2048 + k * 1024); } while (0)
#define PG8_LDB(dst, b, h) do { _Pragma("unroll") for (int n = 0; n < 2; ++n) _Pragma("unroll") for (int k = 0; k < 2; ++k) dst[n][k] = *(const LAS bf16x8*)(lds + PG8_SB(b, h) + boff + n * 2048 + k * 1024); } while (0)
#define PG8_MMA(ai, bj, At, Bt) do { __builtin_amdgcn_s_setprio(1); _Pragma("unroll") for (int m = 0; m < 4; ++m) _Pragma("unroll") for (int n = 0; n < 2; ++n) _Pragma("unroll") for (int k = 0; k < 2; ++k) \
        acc[ai][bj][m][n] = __builtin_amdgcn_mfma_f32_16x16x32_bf16(Bt[n][k], At[m][k], acc[ai][bj][m][n], 0, 0, 0); __builtin_amdgcn_s_setprio(0); } while (0)
#define PG8_WAIT_V(n) asm volatile("s_waitcnt vmcnt(" #n ")" ::: "memory")
#define PG8_WAIT_L(n) asm volatile("s_waitcnt lgkmcnt(" #n ")" ::: "memory")
#define PG8_BAR __builtin_amdgcn_s_barrier()
#define PG8_SCHED __builtin_amdgcn_sched_barrier(0)
    Unit cur, nxt; int ui = 0;
    if (!S.next(0, cur)) return;
    f32x4 acc[2][2][4][2];
#pragma unroll
    for (int a = 0; a < 2; ++a)
#pragma unroll
        for (int b = 0; b < 2; ++b)
#pragma unroll
            for (int m = 0; m < 4; ++m)
#pragma unroll
                for (int n = 0; n < 2; ++n) acc[a][b][m][n] = (f32x4){0.f, 0.f, 0.f, 0.f};
    bf16x8 At[4][2], B0[2][2], B1[2][2];
    const char* cA = (const char*)g.A + (size_t)cur.pm * tstepA; const char* cB = (const char*)g.Bt + (size_t)cur.pn * tstepB;
    PG8_STAGE(PG8_SB(0, 0), cB, voffB); PG8_STAGE(PG8_SB(0, 1), cB + hstepB, voffB); PG8_STAGE(PG8_SA(0, 0), cA, voffA); PG8_STAGE(PG8_SA(0, 1), cA + hstepA, voffA);
    if (wr == 1) PG8_BAR;
    PG8_WAIT_V(2); PG8_BAR;
    PG8_STAGE(PG8_SB(1, 0), cB + kstep, voffB); PG8_STAGE(PG8_SA(1, 0), cA + kstep, voffA); PG8_STAGE(PG8_SB(1, 1), cB + hstepB + kstep, voffB);
    PG8_WAIT_V(6); PG8_BAR;
    for (;;) {
        const bool has_next = S.next(ui + 1, nxt);
        const char* nA = has_next ? (const char*)g.A + (size_t)nxt.pm * tstepA : cA; const char* nB = has_next ? (const char*)g.Bt + (size_t)nxt.pn * tstepB : cB;
        for (int t = 0; t < nt; t += 2) {
            if constexpr (Epi::HOOK) { if (t == nt / 2) E.hook(acc, cur, wr, wc, fr, fq); }
            const bool last = (t == nt - 2);
            const char* a1 = cA + (size_t)(t + 1) * kstep;
            const char* a2 = last ? nA : cA + (size_t)(t + 2) * kstep; const char* b2 = last ? nB : cB + (size_t)(t + 2) * kstep;
            const char* a3 = a2 + kstep; const char* b3 = b2 + kstep;
            PG8_LDB(B0, 0, 0); PG8_LDB(B1, 0, 1); PG8_SCHED; PG8_LDA(At, 0, 0); PG8_STAGE(PG8_SA(1, 1), a1 + hstepA, voffA);
            PG8_WAIT_V(8); PG8_WAIT_L(0); PG8_BAR; PG8_MMA(0, 0, At, B0); PG8_MMA(0, 1, At, B1); PG8_BAR; PG8_SCHED;
            PG8_LDA(At, 0, 1); PG8_STAGE(PG8_SB(0, 0), b2, voffB); PG8_STAGE(PG8_SB(0, 1), b2 + hstepB, voffB); PG8_STAGE(PG8_SA(0, 0), a2, voffA);
            PG8_WAIT_V(8); PG8_WAIT_L(0); PG8_BAR; PG8_MMA(1, 0, At, B0); PG8_MMA(1, 1, At, B1); PG8_BAR; PG8_SCHED;
            PG8_LDB(B0, 1, 0); PG8_LDB(B1, 1, 1); PG8_SCHED; PG8_LDA(At, 1, 0); PG8_STAGE(PG8_SA(0, 1), a2 + hstepA, voffA);
            PG8_WAIT_V(8); PG8_WAIT_L(0); PG8_BAR; PG8_MMA(0, 0, At, B0); PG8_MMA(0, 1, At, B1); PG8_BAR; PG8_SCHED;
            PG8_LDA(At, 1, 1); PG8_STAGE(PG8_SB(1, 0), b3, voffB); PG8_STAGE(PG8_SB(1, 1), b3 + hstepB, voffB); PG8_STAGE(PG8_SA(1, 0), a3, voffA);
            PG8_WAIT_V(8); PG8_WAIT_L(0); PG8_BAR; PG8_MMA(1, 0, At, B0); PG8_MMA(1, 1, At, B1); PG8_BAR; PG8_SCHED;
        }
        if constexpr (ALIGN_EPI) { if (wr == 0) PG8_BAR; }
        E(acc, cur, wr, wc, fr, fq);
        if (!has_next) break;
#pragma unroll
        for (int a = 0; a < 2; ++a)
#pragma unroll
            for (int b = 0; b < 2; ++b)
#pragma unroll
                for (int m = 0; m < 4; ++m)
#pragma unroll
                    for (int n = 0; n < 2; ++n) acc[a][b][m][n] = (f32x4){0.f, 0.f, 0.f, 0.f};
        cur = nxt; cA = nA; cB = nB; ++ui;
        if constexpr (ALIGN_EPI) { if (wr == 1) PG8_BAR; }
    }
    PG8_WAIT_V(0);
    if constexpr (!ALIGN_EPI) { if (wr == 0) PG8_BAR; }
    PG8_BAR;
#undef PG8_SA
#undef PG8_SB
#undef PG8_STAGE
#undef PG8_LDA
#undef PG8_LDB
#undef PG8_MMA
#undef PG8_WAIT_V
#undef PG8_WAIT_L
#undef PG8_BAR
#undef PG8_SCHED
}
}

__device__ __forceinline__ unsigned pk2(float lo, float hi) { f32x2 v = {lo, hi}; bf16x2_t b = __builtin_convertvector(v, bf16x2_t); return __builtin_bit_cast(unsigned, b); }
__device__ __forceinline__ float bf_lo(unsigned u) { return __uint_as_float(u << 16); }
__device__ __forceinline__ float bf_hi(unsigned u) { return __uint_as_float(u & 0xffff0000u); }
__device__ __forceinline__ float rcpf(float x) { return __builtin_amdgcn_rcpf(x); }
__device__ __forceinline__ float sigmoidf_(float x) { return rcpf(1.f + __expf(-x)); }
__device__ __forceinline__ float siluf_(float x) { return x * sigmoidf_(x); }
template <int MASK> __device__ __forceinline__ float shx(float v) {
    if constexpr (MASK < 32) return __builtin_bit_cast(float, __builtin_amdgcn_ds_swizzle(__builtin_bit_cast(int, v), (MASK << 10) | 0x1f));
    else { int self = (int)__builtin_amdgcn_mbcnt_hi(~0u, __builtin_amdgcn_mbcnt_lo(~0u, 0u)); asm volatile("" : "+v"(self)); return __builtin_bit_cast(float, __builtin_amdgcn_ds_bpermute((self ^ MASK) << 2, __builtin_bit_cast(int, v))); }
}
__device__ __forceinline__ float wave_sum(float v) {
    v += shx<1>(v); v += shx<2>(v); v += shx<4>(v); v += shx<8>(v); v += shx<16>(v); v += shx<32>(v);
    return v;
}
#define LDS_WAIT() asm volatile("s_waitcnt lgkmcnt(0)" ::: "memory")
#define MFMA32(a, b, c) __builtin_amdgcn_mfma_f32_32x32x16_bf16((a), (b), (c), 0, 0, 0)
__device__ __forceinline__ int crow(int e, int hh) { return (e & 3) + 8 * (e >> 2) + 4 * hh; }

using pg8::Unit;
typedef const f32x4 (&AccRef)[2][2][4][2];

#define NT_STORE16(ptr, val) __builtin_nontemporal_store((val), (u32x4*)(void*)(ptr))
__device__ __forceinline__ float fast_sigmoid(float x) { return rcpf(1.f + __builtin_amdgcn_exp2f(x * -1.4426950408889634f)); }
struct EpiG1 {
    static constexpr bool HOOK = false;
    const LAS float* rs; const float* lb; const float* rope; bf16_t* QA; _Float16* LOGF; bf16_t* V; bf16_t* GH; bf16_t* AK; bf16_t* AV;
    template <int KIND> __device__ __forceinline__ void run(AccRef acc, const Unit& u, int wr, int wc, int fr, int fq, bf16_t* dst, int ldd, int cl, float scale) const {
        const int row0 = u.pm * 256 + wr * 64 + fr;
        f32x4 l0[2], l1[2];
        if (KIND == 1) {
#pragma unroll
            for (int bj = 0; bj < 2; ++bj) { l0[bj] = *(const f32x4*)(lb + cl + bj * 128); l1[bj] = *(const f32x4*)(lb + cl + bj * 128 + 4); }
        }
        f32x4 rn[4];
        if (KIND == 3) { const int pos = row0 & (SEQ - 1);
#pragma unroll
            for (int k = 0; k < 4; ++k) rn[k] = *(const f32x4*)(rope + pos * 16 + 4 * k); }
#pragma unroll
        for (int ai = 0; ai < 2; ++ai)
#pragma unroll
            for (int m = 0; m < 4; ++m) {
                const int row = row0 + ai * 128 + m * 16;
                const float rstd = rs[u.idx * 256 + wr * 64 + fr + ai * 128 + m * 16];
                f32x4 c0, c1, s0, s1;
                if (KIND == 3) {
                    c0 = rn[0]; c1 = rn[1]; s0 = rn[2]; s1 = rn[3];
                    if (ai * 4 + m + 1 < 8) { const int gi = ai * 4 + m + 1, pos = (row0 + (gi >> 2) * 128 + (gi & 3) * 16) & (SEQ - 1);
#pragma unroll
                        for (int k = 0; k < 4; ++k) rn[k] = *(const f32x4*)(rope + pos * 16 + 4 * k); }
                }
#pragma unroll
                for (int bj = 0; bj < 2; ++bj) {
                    float v[8];
#pragma unroll
                    for (int e = 0; e < 4; ++e) { v[e] = acc[ai][bj][m][0][e] * rstd; v[4 + e] = acc[ai][bj][m][1][e] * rstd; }
                    const int c = cl + bj * 128;
                    u32x4 w;
                    if (KIND == 0) {
#pragma unroll
                        for (int e = 0; e < 8; ++e) v[e] = v[e] * fast_sigmoid(v[e]);
                    } else if (KIND == 1) {
                        _Float16 h[8];
#pragma unroll
                        for (int e = 0; e < 8; ++e) { const float lbv = e < 4 ? l0[bj][e] : l1[bj][e - 4]; const float f = lbv + (1.f - lbv) * fast_sigmoid(v[e]);
                            h[e] = (_Float16)(__builtin_amdgcn_logf(fmaxf(f, 1e-30f)) * 0.6931471805599453f); }
#pragma unroll
                        for (int e = 0; e < 4; ++e) w[e] = (unsigned)__builtin_bit_cast(unsigned short, h[2 * e]) | ((unsigned)__builtin_bit_cast(unsigned short, h[2 * e + 1]) << 16);
                    } else if (KIND == 3) {
                        if ((wc & 1) == 0) {
#pragma unroll
                            for (int e = 0; e < 8; ++e) {
                                const float cs = e < 4 ? c0[e] : c1[e - 4], sn = e < 4 ? s0[e] : s1[e - 4];
                                const float p = shx<16>(v[e]);
                                const float r = (fq == 0) ? (v[e] * cs - p * sn) : (v[e] * cs + p * sn);
                                v[e] = (fq < 2) ? r : v[e];
                            }
                        }
#pragma unroll
                        for (int e = 0; e < 8; ++e) v[e] *= scale;
                    }
                    if (KIND != 1) { w = (u32x4){pk2(v[0], v[1]), pk2(v[2], v[3]), pk2(v[4], v[5]), pk2(v[6], v[7])}; }
                    NT_STORE16(dst + (size_t)row * ldd + c, w);
                }
            }
    }
    __device__ __forceinline__ void operator()(AccRef acc, const Unit& u, int wr, int wc, int fr, int fq) const {
        const int pn = u.pn;
        const int cl = (pn < 20 ? (pn & 3) * 256 : 0) + wc * 32 + 8 * fq;
        if (pn < 4) run<0>(acc, u, wr, wc, fr, fq, QA, QP, cl, 1.f);
        else if (pn < 8) run<1>(acc, u, wr, wc, fr, fq, (bf16_t*)LOGF, 1024, cl, 1.f);
        else if (pn < 12) run<2>(acc, u, wr, wc, fr, fq, V, 1024, cl, 1.f);
        else if (pn < 16) run<0>(acc, u, wr, wc, fr, fq, GH, 1024, cl, 1.f);
        else if (pn < 20) run<3>(acc, u, wr, wc, fr, fq, QA + 1024, QP, cl, 0.125f);
        else if (pn == 20) run<3>(acc, u, wr, wc, fr, fq, AK, 256, cl, 1.f);
        else run<2>(acc, u, wr, wc, fr, fq, AV, 256, cl, 1.f);
    }
};

struct EpiGate {
    static constexpr bool HOOK = false;
    const LAS float* rs; bf16_t* G; bf16_t* G2;
    __device__ __forceinline__ void operator()(AccRef acc, const Unit& u, int wr, int wc, int fr, int fq) const {
        const int row0 = u.pm * 256 + wr * 64 + fr, c0 = (u.pn & 3) * 256 + wc * 32 + 8 * fq; bf16_t* G = u.pn < 4 ? this->G : G2;
#pragma unroll
        for (int ai = 0; ai < 2; ++ai)
#pragma unroll
            for (int m = 0; m < 4; ++m) {
                const int row = row0 + ai * 128 + m * 16;
                const float rstd = rs[u.idx * 256 + wr * 64 + fr + ai * 128 + m * 16];
#pragma unroll
                for (int bj = 0; bj < 2; ++bj) {
                    float v[8];
#pragma unroll
                    for (int e = 0; e < 4; ++e) { v[e] = sigmoidf_(acc[ai][bj][m][0][e] * rstd); v[4 + e] = sigmoidf_(acc[ai][bj][m][1][e] * rstd); }
                    u32x4 w = {pk2(v[0], v[1]), pk2(v[2], v[3]), pk2(v[4], v[5]), pk2(v[6], v[7])};
                    NT_STORE16(G + (size_t)row * 1024 + c0 + bj * 128, w);
                }
            }
    }
};
struct EpiMixK {
    static constexpr bool HOOK = true;
    const bf16_t* GA; const bf16_t* GB; bf16_t* MIX;
    static __device__ __forceinline__ unsigned goff(int gi) { return (unsigned)(((((gi >> 3) & 1) * 128 + ((gi >> 1) & 3) * 16) * 1024 + (gi & 1) * 128) * 2); }
    __device__ __forceinline__ void hook(f32x4 (&acc)[2][2][4][2], const Unit& u, int wr, int wc, int fr, int fq) const {
        int row0 = u.pm * 256 + wr * 64 + fr; const int c0 = u.pn * 256 + wc * 32 + 8 * fq;
        asm volatile("" : "+v"(row0));
        const unsigned vb = ((unsigned)row0 * 1024u + (unsigned)c0) * 2u;
#pragma unroll
        for (int h8 = 0; h8 < 2; ++h8) {
            u32x4 ga[8], gb[8];
#pragma unroll
            for (int k = 0; k < 8; ++k) { ga[k] = *(const u32x4*)((const char*)GA + vb + goff(8 * h8 + k)); gb[k] = *(const u32x4*)((const char*)GB + vb + goff(8 * h8 + k)); }
            asm volatile("" ::: "memory");
#pragma unroll
            for (int k = 0; k < 8; ++k) {
                const int gi = 8 * h8 + k, ai = (gi >> 3) & 1, m = (gi >> 1) & 3, bj = gi & 1;
#pragma unroll
                for (int e = 0; e < 4; ++e) {
                    const float r0 = bf_lo(ga[k][e]) * rcpf(fmaxf(bf_lo(gb[k][e]), 1e-30f)), r1 = bf_hi(ga[k][e]) * rcpf(fmaxf(bf_hi(gb[k][e]), 1e-30f));
                    if (e < 2) { acc[ai][bj][m][0][2 * e] *= r0; acc[ai][bj][m][0][2 * e + 1] *= r1; } else { acc[ai][bj][m][1][2 * e - 4] *= r0; acc[ai][bj][m][1][2 * e - 3] *= r1; }
                }
            }
            asm volatile("" ::: "memory");
        }
    }
    __device__ __forceinline__ void operator()(AccRef acc, const Unit& u, int wr, int wc, int fr, int fq) const {
        const int row0 = u.pm * 256 + wr * 64 + fr, c0 = u.pn * 256 + wc * 32 + 8 * fq;
        const unsigned vb = ((unsigned)row0 * 1024u + (unsigned)c0) * 2u;
#pragma unroll
        for (int q4 = 0; q4 < 2; ++q4) {
            u32x4 gb[8];
#pragma unroll
            for (int k = 0; k < 8; ++k) gb[k] = *(const u32x4*)((const char*)GB + vb + goff(8 * q4 + k));
            asm volatile("" ::: "memory");
#pragma unroll
            for (int k = 0; k < 8; ++k) {
                const int gi = 8 * q4 + k, ai = (gi >> 3) & 1, m = (gi >> 1) & 3, bj = gi & 1;
                u32x4 w;
#pragma unroll
                for (int e = 0; e < 4; ++e) {
                    const float a0 = e < 2 ? acc[ai][bj][m][0][2 * e] : acc[ai][bj][m][1][2 * e - 4], a1 = e < 2 ? acc[ai][bj][m][0][2 * e + 1] : acc[ai][bj][m][1][2 * e - 3];
                    w[e] = pk2(a0 * bf_lo(gb[k][e]), a1 * bf_hi(gb[k][e]));
                }
                NT_STORE16((const char*)MIX + vb + goff(gi), w);
            }
        }
    }
};
struct EpiRes {   static constexpr bool HOOK = false;
    bf16_t* XB; float* sspout;
    __device__ __forceinline__ void operator()(AccRef acc, const Unit& u, int wr, int wc, int fr, int fq) const {
        const int row0 = u.pm * 256 + wr * 64 + fr, c0 = u.pn * 256 + wc * 32 + 8 * fq;
        u32x4 bs[2][4][2];
#pragma unroll
        for (int ai = 0; ai < 2; ++ai)
#pragma unroll
            for (int m = 0; m < 4; ++m)
#pragma unroll
                for (int bj = 0; bj < 2; ++bj) bs[ai][m][bj] = *(const u32x4*)(XB + (size_t)(row0 + ai * 128 + m * 16) * 1024 + c0 + bj * 128);
        asm volatile("" ::: "memory");
#pragma unroll
        for (int ai = 0; ai < 2; ++ai)
#pragma unroll
            for (int m = 0; m < 4; ++m) {
                const int row = row0 + ai * 128 + m * 16; float sq = 0.f;
#pragma unroll
                for (int bj = 0; bj < 2; ++bj) {
                    const size_t off = (size_t)row * 1024 + c0 + bj * 128;
                    const u32x4 b = bs[ai][m][bj];
                    u32x4 w;
#pragma unroll
                    for (int e = 0; e < 4; ++e) {
                        const float a0 = e < 2 ? acc[ai][bj][m][0][2 * e] : acc[ai][bj][m][1][2 * e - 4], a1 = e < 2 ? acc[ai][bj][m][0][2 * e + 1] : acc[ai][bj][m][1][2 * e - 3];
                        w[e] = pk2(bf_lo(b[e]) + a0, bf_hi(b[e]) + a1);
                        const float r0 = bf_lo(w[e]), r1 = bf_hi(w[e]); sq += r0 * r0 + r1 * r1;
                    }
                    *(u32x4*)(XB + off) = w;
                }
                sq += shx<16>(sq); sq += shx<32>(sq);
                if (fq == 0) sspout[(size_t)row * 16 + u.pn * 4 + wc] = sq;
            }
    }
};
struct EpiSwiglu {
    static constexpr bool HOOK = false;
    const LAS float* rs; bf16_t* ACT;
    __device__ __forceinline__ void operator()(AccRef acc, const Unit& u, int wr, int wc, int fr, int fq) const {
        const int row0 = u.pm * 256 + wr * 64 + fr, c0 = u.pn * 128 + wc * 32 + 8 * fq;
#pragma unroll
        for (int ai = 0; ai < 2; ++ai)
#pragma unroll
            for (int m = 0; m < 4; ++m) {
                const int row = row0 + ai * 128 + m * 16;
                const float rstd = rs[u.idx * 256 + wr * 64 + fr + ai * 128 + m * 16];
                float v[8];
#pragma unroll
                for (int e = 0; e < 4; ++e) { v[e] = siluf_(acc[ai][0][m][0][e] * rstd) * (acc[ai][1][m][0][e] * rstd); v[4 + e] = siluf_(acc[ai][0][m][1][e] * rstd) * (acc[ai][1][m][1][e] * rstd); }
                u32x4 w = {pk2(v[0], v[1]), pk2(v[2], v[3]), pk2(v[4], v[5]), pk2(v[6], v[7])};
                NT_STORE16(ACT + (size_t)row * FF + c0, w);
            }
    }
};

#define CV_LOAD(dst, k0_, n0_) do { _Pragma("unroll") for (int i = 0; i < 32; ++i) dst[i] = W[(size_t)((k0_) + 2 * i + (lane >> 5)) * N + (n0_) + (lane & 31)]; } while (0)
__device__ __forceinline__ void convert_matrix(const float* W, int K, int N, const float* gain, bf16_t* WT, int mode, LAS float* scr, int gw, int NGW, int lane, int& ioff, int ldt = 0) {
    if (ldt == 0) ldt = K;
    const int nblk = N / 32, nitems = (K / 64) * nblk;
    int it0 = (gw - ioff) % NGW; if (it0 < 0) it0 += NGW;
    ioff = (ioff + nitems) % NGW;
    float wn[32];
    if (it0 < nitems) CV_LOAD(wn, (it0 / nblk) * 64, (it0 % nblk) * 32);
    const int c = lane & 7;
    for (int it = it0; it < nitems; it += NGW) {
        const int kb = it / nblk, nb = it % nblk, n0 = nb * 32, k0 = kb * 64;
        const int dst = mode == 0 ? n0 : 256 * (n0 / 128) + (n0 % 128) + (mode == 2 ? 128 : 0);
        f32x4 g0 = {1.f, 1.f, 1.f, 1.f}, g1 = {1.f, 1.f, 1.f, 1.f};
        if (gain) { g0 = *(const f32x4*)(gain + k0 + 8 * c); g1 = *(const f32x4*)(gain + k0 + 8 * c + 4); }
#pragma unroll
        for (int i = 0; i < 32; ++i) scr[(2 * i + (lane >> 5)) * 33 + (lane & 31)] = wn[i];
        const int itn = it + NGW;
        if (itn < nitems) CV_LOAD(wn, (itn / nblk) * 64, (itn % nblk) * 32);
        LDS_WAIT(); asm volatile("" ::: "memory");
#pragma unroll
        for (int j = 0; j < 4; ++j) { const int n = (lane >> 3) + 8 * j; const LAS float* s = scr + (8 * c) * 33 + n;
            u32x4 o = {pk2(s[0 * 33] * g0[0], s[1 * 33] * g0[1]), pk2(s[2 * 33] * g0[2], s[3 * 33] * g0[3]), pk2(s[4 * 33] * g1[0], s[5 * 33] * g1[1]), pk2(s[6 * 33] * g1[2], s[7 * 33] * g1[3])};
            *(u32x4*)(WT + (size_t)(dst + n) * ldt + k0 + 8 * c) = o; }
        LDS_WAIT(); asm volatile("" ::: "memory");
    }
}
#undef CV_LOAD

constexpr int H_QT = 0, H_KC = 17408, H_KCT = 34816, H_VT = 53248, H_SBT = 71680, H_OST = 106496, H_ER = 140288, H_PFX = 140800;
constexpr int H_HGW = H_PFX + 4096;
static_assert(H_HGW + 512 <= LDS_XB, "hgrn lds");
template <bool OUT>
__device__ __forceinline__ void hgrn_unit(LAS unsigned char* lds, int unit, const _Float16* LOGF, bf16_t* QA, const bf16_t* V, const bf16_t* GH, const float* hgw  ,
                                          float* ST, float* HD) {
    const int tid = fresh_tid(), w = __builtin_amdgcn_readfirstlane(tid >> 6), lane = tid & 63, n = lane & 31, hh = lane >> 5;
    const int bh = unit / NSC, sc = unit % NSC, b = bh / HGH, h = bh % HGH;
    const int cb = w & 3, dvb0 = 2 * (w >> 2);
    const int tbO = w >> 2, dvbO = w & 3;
    LAS float* ER = (LAS float*)(lds + H_ER); LAS float* PFX = (LAS float*)(lds + H_PFX);
    f32x16 S[2];
#pragma unroll
    for (int e = 0; e < 16; ++e) { S[0][e] = 0.f; S[1][e] = 0.f; }
    if (OUT && sc > 0) {
        f32x4 wg[4];
#pragma unroll
        for (int jj = 0; jj < 4; ++jj) wg[jj] = (f32x4){1.f, 1.f, 1.f, 1.f};
        f32x16 L0[2], L1[2], L2[2]; f32x4 d0[4], d1[4], d2[4];
#define HG_LDSTATE(L_, d_, jj_) do { const bool ok_ = (jj_) >= 0; const int uj_ = bh * NSC + (ok_ ? (jj_) : 0); const unsigned* Lp_ = (const unsigned*)ST + (size_t)uj_ * 8192 + (size_t)(w * 16) * 64 + lane; \
            _Pragma("unroll") for (int tl = 0; tl < 2; ++tl) _Pragma("unroll") for (int e = 0; e < 8; ++e) { const unsigned pw_ = ok_ ? Lp_[(tl * 8 + e) * 64] : 0u; L_[tl][2 * e] = bf_lo(pw_); L_[tl][2 * e + 1] = bf_hi(pw_); } \
            _Pragma("unroll") for (int q = 0; q < 4; ++q) d_[q] = ok_ ? *(const f32x4*)(HD + (size_t)uj_ * 128 + 32 * cb + 8 * q + 4 * hh) : (f32x4){1.f, 1.f, 1.f, 1.f}; } while (0)
#define HG_ACC(L_, d_) do { _Pragma("unroll") for (int tl = 0; tl < 2; ++tl) _Pragma("unroll") for (int e = 0; e < 16; ++e) S[tl][e] += wg[e >> 2][e & 3] * L_[tl][e]; \
            _Pragma("unroll") for (int q = 0; q < 4; ++q) wg[q] *= d_[q]; } while (0)
        for (int j = sc - 1; j >= 0; j -= 3) {
            HG_LDSTATE(L0, d0, j); HG_LDSTATE(L1, d1, j - 1); HG_LDSTATE(L2, d2, j - 2);
            HG_ACC(L0, d0); HG_ACC(L1, d1); HG_ACC(L2, d2);
        }
#undef HG_ACC
#undef HG_LDSTATE
    }
    float dlog0 = 0.f, dlog1 = 0.f;
    const int c0 = 2 * lane;
    if (OUT && tid < 128) *(LAS float*)(lds + H_HGW + tid * 4) = hgw[h * 128 + tid];
    const size_t tok_sc = (size_t)b * SEQ + (size_t)sc * SC_TOK;
    unsigned gq[8], qq[8], vq[8];
#define HG_LOAD(chn) do { const size_t t0_ = tok_sc + (size_t)(chn) * CH; _Pragma("unroll") for (int i = 0; i < 8; ++i) { const size_t row_ = t0_ + 8 * w + i; \
        gq[i] = *(const unsigned*)(LOGF + row_ * 1024 + h * 128 + c0); vq[i] = *(const unsigned*)(V + row_ * 1024 + h * 128 + c0); \
        if (OUT) qq[i] = *(const unsigned*)(QA + row_ * QP + h * 128 + c0); } } while (0)
#pragma unroll 1
    for (int ch = 0; ch < NCH; ++ch) {
        const size_t tok0 = tok_sc + (size_t)ch * CH;
        if (ch == 0) HG_LOAD(0);
        float b0[8], b1[8]; float a0 = 0.f, a1 = 0.f;
#pragma unroll
        for (int i = 0; i < 8; ++i) {
            const float g0 = (float)__builtin_bit_cast(_Float16, (unsigned short)(gq[i] & 0xffffu)), g1 = (float)__builtin_bit_cast(_Float16, (unsigned short)(gq[i] >> 16));
            a0 += g0; a1 += g1; b0[i] = a0; b1[i] = a1;
        }
        *(LAS f32x2*)(PFX + w * 128 + c0) = (f32x2){a0, a1};
        LDS_WAIT(); __builtin_amdgcn_s_barrier(); asm volatile("" ::: "memory");
        float p0 = 0.f, p1 = 0.f, t0 = 0.f, t1 = 0.f;
#pragma unroll
        for (int ww = 0; ww < 8; ++ww) { const f32x2 x = *(const LAS f32x2*)(PFX + ww * 128 + c0); t0 += x.x; t1 += x.y; if (ww < w) { p0 += x.x; p1 += x.y; } }
        const float r0 = 0.5f * t0, r1 = 0.5f * t1;
        if (w == 0) *(LAS f32x2*)(ER + c0) = (f32x2){__expf(r0), __expf(r1)};
        dlog0 += t0; dlog1 += t1;
        float kc0[8], kc1[8];
#pragma unroll
        for (int i = 0; i < 8; ++i) {
            const float g0 = (float)__builtin_bit_cast(_Float16, (unsigned short)(gq[i] & 0xffffu)), g1 = (float)__builtin_bit_cast(_Float16, (unsigned short)(gq[i] >> 16));
            const float bt0 = p0 + b0[i], bt1 = p1 + b1[i];
            kc0[i] = (1.f - __expf(g0)) * __expf(r0 - bt0); kc1[i] = (1.f - __expf(g1)) * __expf(r1 - bt1);
            if (OUT) {
                const float q0 = bf_lo(qq[i]) * __expf(bt0 - r0), q1 = bf_hi(qq[i]) * __expf(bt1 - r1);
                const int t = 8 * w + i;
                *(LAS unsigned*)(lds + H_QT + t * 272 + c0 * 2) = pk2(q0, q1);
                *(LAS unsigned*)(lds + H_KC + t * 272 + c0 * 2) = pk2(kc0[i], kc1[i]);
            }
        }
        {
            u32x4 k0v = {pk2(kc0[0], kc0[1]), pk2(kc0[2], kc0[3]), pk2(kc0[4], kc0[5]), pk2(kc0[6], kc0[7])};
            u32x4 k1v = {pk2(kc1[0], kc1[1]), pk2(kc1[2], kc1[3]), pk2(kc1[4], kc1[5]), pk2(kc1[6], kc1[7])};
            *(LAS u32x4*)(lds + H_KCT + c0 * 144 + 16 * w) = k0v; *(LAS u32x4*)(lds + H_KCT + (c0 + 1) * 144 + 16 * w) = k1v;
            u32x4 v0v, v1v;
#pragma unroll
            for (int i = 0; i < 4; ++i) { v0v[i] = (vq[2 * i] & 0xffffu) | (vq[2 * i + 1] << 16); v1v[i] = (vq[2 * i] >> 16) | (vq[2 * i + 1] & 0xffff0000u); }
            *(LAS u32x4*)(lds + H_VT + c0 * 144 + 16 * w) = v0v; *(LAS u32x4*)(lds + H_VT + (c0 + 1) * 144 + 16 * w) = v1v;
        }
        LDS_WAIT(); __builtin_amdgcn_s_barrier(); asm volatile("" ::: "memory");
        if (ch + 1 < NCH) HG_LOAD(ch + 1);
        u32x4 gg0 = {0u, 0u, 0u, 0u}, gg1 = {0u, 0u, 0u, 0u};
        if (OUT) { const size_t grow = tok0 + (tid >> 3); gg0 = *(const u32x4*)(GH + grow * 1024 + h * 128 + 16 * (tid & 7)); gg1 = *(const u32x4*)(GH + grow * 1024 + h * 128 + 16 * (tid & 7) + 8); }
        f32x4 er[4];
#pragma unroll
        for (int jj = 0; jj < 4; ++jj) er[jj] = *(const LAS f32x4*)(ER + 32 * cb + 8 * jj + 4 * hh);
        asm volatile("" ::: "memory");
#pragma unroll
        for (int tl = 0; tl < 2; ++tl) {
#pragma unroll
            for (int e = 0; e < 16; ++e) S[tl][e] *= er[e >> 2][e & 3];
            if (OUT) {
#pragma unroll
                for (int jj = 0; jj < 4; ++jj) { u32x2 pw = {pk2(S[tl][4 * jj], S[tl][4 * jj + 1]), pk2(S[tl][4 * jj + 2], S[tl][4 * jj + 3])};
                    *(LAS u32x2*)(lds + H_SBT + (32 * (dvb0 + tl) + n) * 272 + (32 * cb + 8 * jj + 4 * hh) * 2) = pw; }
            }
        }
        if (OUT) {
            LDS_WAIT(); __builtin_amdgcn_s_barrier(); asm volatile("" ::: "memory");
            bf16x8 qf[8];
#pragma unroll
            for (int ks = 0; ks < 8; ++ks) qf[ks] = *(const LAS bf16x8*)(lds + H_QT + (32 * tbO + n) * 272 + (16 * ks + 8 * hh) * 2);
            f32x16 O, O2, O3;
#pragma unroll
            for (int e = 0; e < 16; ++e) { O[e] = 0.f; O2[e] = 0.f; O3[e] = 0.f; }
#pragma unroll
            for (int sb = 0; sb < 2; ++sb) {
                if (sb <= tbO) {
                    f32x16 P;
#pragma unroll
                    for (int e = 0; e < 16; ++e) P[e] = 0.f;
#pragma unroll
                    for (int ks = 0; ks < 8; ++ks) { const bf16x8 kf = *(const LAS bf16x8*)(lds + H_KC + (32 * sb + n) * 272 + (16 * ks + 8 * hh) * 2); P = MFMA32(kf, qf[ks], P); }
                    if (sb == tbO) {
#pragma unroll
                        for (int e = 0; e < 16; ++e) P[e] = (crow(e, hh) <= n) ? P[e] : 0.f;
                    }
#pragma unroll
                    for (int k2 = 0; k2 < 2; ++k2) {
                        u32x4 pp = {pk2(P[8 * k2], P[8 * k2 + 1]), pk2(P[8 * k2 + 2], P[8 * k2 + 3]), pk2(P[8 * k2 + 4], P[8 * k2 + 5]), pk2(P[8 * k2 + 6], P[8 * k2 + 7])};
                        const bf16x8 pa = __builtin_bit_cast(bf16x8, pp);
                        const LAS unsigned char* vp = lds + H_VT + (32 * dvbO + n) * 144 + (32 * sb + 16 * k2 + 4 * hh) * 2;
                        const s16x4 lo = *(const LAS s16x4*)vp, hi = *(const LAS s16x4*)(vp + 16);
                        const bf16x8 vb = __builtin_shufflevector(lo, hi, 0, 1, 2, 3, 4, 5, 6, 7);
                        O = MFMA32(pa, vb, O);
                    }
                }
            }
#pragma unroll
            for (int ks = 0; ks < 8; ++ks) { const bf16x8 sf = *(const LAS bf16x8*)(lds + H_SBT + (32 * dvbO + n) * 272 + (16 * ks + 8 * hh) * 2); if (ks & 1) O3 = MFMA32(qf[ks], sf, O3); else O2 = MFMA32(qf[ks], sf, O2); }
#pragma unroll
            for (int e = 0; e < 16; ++e) *(LAS float*)(lds + H_OST + (32 * tbO + crow(e, hh)) * 528 + (32 * dvbO + n) * 4) = O[e] + (O2[e] + O3[e]);
        }
#pragma unroll
        for (int ks = 0; ks < 4; ++ks) {
            const bf16x8 a = *(const LAS bf16x8*)(lds + H_KCT + (32 * cb + n) * 144 + (16 * ks + 8 * hh) * 2);
#pragma unroll
            for (int tl = 0; tl < 2; ++tl) { const bf16x8 bb = *(const LAS bf16x8*)(lds + H_VT + (32 * (dvb0 + tl) + n) * 144 + (16 * ks + 8 * hh) * 2); S[tl] = MFMA32(a, bb, S[tl]); }
        }
        {
            f32x4 er2[4];
#pragma unroll
            for (int jj = 0; jj < 4; ++jj) er2[jj] = *(const LAS f32x4*)(ER + 32 * cb + 8 * jj + 4 * hh);
#pragma unroll
            for (int tl = 0; tl < 2; ++tl)
#pragma unroll
                for (int e = 0; e < 16; ++e) S[tl][e] *= er2[e >> 2][e & 3];
        }
        if (OUT) {
            LDS_WAIT(); __builtin_amdgcn_s_barrier(); asm volatile("" ::: "memory");
            const int t = tid >> 3, cq = tid & 7;
            const size_t row = tok0 + t;
            const u32x4 g0 = gg0, g1 = gg1;
            f32x4 o[4]; float sq = 0.f;
#pragma unroll
            for (int i = 0; i < 4; ++i) { o[i] = *(const LAS f32x4*)(lds + H_OST + t * 528 + (16 * cq + 4 * i) * 4); sq += (o[i][0] * o[i][0] + o[i][1] * o[i][1]) + (o[i][2] * o[i][2] + o[i][3] * o[i][3]); }
            sq += shx<1>(sq); sq += shx<2>(sq); sq += shx<4>(sq);
            const float rs = rsqrtf(sq * (1.f / 128.f) + EPS);
            float r[16];
#pragma unroll
            for (int i = 0; i < 4; ++i) { const f32x4 wv = *(const LAS f32x4*)(lds + H_HGW + (16 * cq + 4 * i) * 4);
#pragma unroll
                for (int e = 0; e < 4; ++e) r[4 * i + e] = o[i][e] * rs * wv[e]; }
            u32x4 w0, w1;
#pragma unroll
            for (int i = 0; i < 4; ++i) { w0[i] = pk2(r[2 * i] * bf_lo(g0[i]), r[2 * i + 1] * bf_hi(g0[i])); w1[i] = pk2(r[8 + 2 * i] * bf_lo(g1[i]), r[8 + 2 * i + 1] * bf_hi(g1[i])); }
            bf16_t* op = QA + row * QP + h * 128 + 16 * cq;
            *(u32x4*)op = w0; *(u32x4*)(op + 8) = w1;
        }
    }
    if (!OUT) {
        unsigned* Lp = (unsigned*)ST + (size_t)unit * 8192 + (size_t)(w * 16) * 64 + lane;
#pragma unroll
        for (int tl = 0; tl < 2; ++tl)
#pragma unroll
            for (int e = 0; e < 8; ++e) Lp[(tl * 8 + e) * 64] = pk2(S[tl][2 * e], S[tl][2 * e + 1]);
        if (w == 0) *(f32x2*)(HD + (size_t)unit * 128 + c0) = (f32x2){__expf(dlog0), __expf(dlog1)};
    }
    LDS_WAIT(); __builtin_amdgcn_s_barrier(); asm volatile("" ::: "memory");
}

constexpr int A_KS = 0, A_VT = 36864;
__device__ __forceinline__ void attn_phase(LAS unsigned char* lds, unsigned* qctr, bf16_t* QA, const bf16_t* AK, const bf16_t* AV, const float* sinks  ) {
    const int tid = fresh_tid(), w = __builtin_amdgcn_readfirstlane(tid >> 6), lane = tid & 63, n = lane & 31, hh = lane >> 5;
    constexpr int NU = BATCH * 128 * 4;
    constexpr float L2E = 1.4426950408889634f;
    const int g = w >> 1;
    volatile LAS unsigned* qw = (volatile LAS unsigned*)(lds + LDS_XB + 128);
    if (tid == 0) qw[0] = __hip_atomic_fetch_add(qctr, 1u, __ATOMIC_RELAXED, __HIP_MEMORY_SCOPE_AGENT);
    __syncthreads();
    int unit = (int)qw[0];
    __syncthreads();
    if (unit >= NU) return;
    u32x4 kr[4], vr[4]; bf16x8 qn[4];
#pragma unroll
    for (int i = 0; i < 4; ++i) { kr[i] = (u32x4){0u, 0u, 0u, 0u}; vr[i] = (u32x4){0u, 0u, 0u, 0u}; }
#define AT_LOADKV(un_) do { const int kvh_ = (un_) & 3, blk_ = ((un_) >> 2) & 127, b_ = (un_) >> 9; const long tb_ = (long)b_ * SEQ + (long)blk_ * 128; const int k0_ = (blk_ == 0) ? 128 : 0; \
        _Pragma("unroll") for (int i = 0; i < 4; ++i) { const int ci = tid + 512 * i; { const int key = ci >> 3, part = ci & 7; if (key >= k0_) kr[i] = *(const u32x4*)(AK + (size_t)(tb_ - 128 + key) * 256 + kvh_ * 64 + part * 8); } \
            { const int key = ci >> 3, part = ci & 7; if (key >= k0_) vr[i] = *(const u32x4*)(AV + (size_t)(tb_ - 128 + key) * 256 + kvh_ * 64 + part * 8); } } } while (0)
#define AT_QROW(un_, qs_) (QA + (size_t)((long)((un_) >> 9) * SEQ + (long)(((un_) >> 2) & 127) * 128 + 32 * (qs_) + n) * QP + 1024 + (((un_) & 3) * 4 + g) * 64)
#define AT_LOADQ(un_, qs_) do { const bf16_t* qr_ = AT_QROW(un_, qs_); _Pragma("unroll") for (int ks = 0; ks < 4; ++ks) qn[ks] = *(const bf16x8*)(qr_ + 16 * ks + 8 * hh); } while (0)
    AT_LOADKV(unit); AT_LOADQ(unit, 2 * (w & 1));
    float sinkn = sinks[(unit & 3) * 4 + g];
#pragma unroll 1
    for (;;) {
        const int kvh = unit & 3, blk = (unit >> 2) & 127;
        if (tid == 0) qw[0] = __hip_atomic_fetch_add(qctr, 1u, __ATOMIC_RELAXED, __HIP_MEMORY_SCOPE_AGENT);
        const int kk0 = (blk == 0) ? 128 : 0;
#pragma unroll
        for (int i = 0; i < 4; ++i) {
            const int ci = tid + 512 * i;
            { const int key = ci >> 3, part = ci & 7; if (key >= kk0) *(LAS u32x4*)(lds + A_KS + key * 144 + part * 16) = kr[i]; }
            { const int key = ci >> 3, part = ci & 7, ksw = key ^ (part << 2); if (key >= kk0) {
#pragma unroll
                for (int e = 0; e < 4; ++e) { *(LAS unsigned short*)(lds + A_VT + (part * 8 + 2 * e) * 528 + ksw * 2) = (unsigned short)(vr[i][e] & 0xffffu); *(LAS unsigned short*)(lds + A_VT + (part * 8 + 2 * e + 1) * 528 + ksw * 2) = (unsigned short)(vr[i][e] >> 16); } } }
        }
        LDS_WAIT(); __builtin_amdgcn_s_barrier(); asm volatile("" ::: "memory");
        const int un = (int)qw[0];
        const float sink = sinkn;
        if (un < NU) { AT_LOADKV(un); sinkn = sinks[(un & 3) * 4 + g]; }
        const int hq = kvh * 4 + g;
#pragma unroll 1
        for (int tk = 0; tk < 2; ++tk) {
            const int qs = 2 * (w & 1) + tk;
            bf16_t* qrow = AT_QROW(unit, qs);
            bf16x8 qf[4];
#pragma unroll
            for (int ks = 0; ks < 4; ++ks) qf[ks] = qn[ks];
            if (tk == 0) AT_LOADQ(unit, qs + 1); else if (un < NU) AT_LOADQ(un, 2 * (w & 1));
            f32x16 P[5];
#pragma unroll
            for (int jt = 0; jt < 5; ++jt) {
                const bool tv = !(blk == 0 && qs + jt < 4);
#pragma unroll
                for (int e = 0; e < 16; ++e) P[jt][e] = 0.f;
                if (tv) {
#pragma unroll
                    for (int ks = 0; ks < 4; ++ks) { const bf16x8 kf = *(const LAS bf16x8*)(lds + A_KS + (32 * qs + 32 * jt + n) * 144 + (16 * ks + 8 * hh) * 2); P[jt] = MFMA32(kf, qf[ks], P[jt]); }
                }
#pragma unroll
                for (int e = 0; e < 16; ++e) {
                    bool ok = tv;
                    if (jt == 0) ok = ok && (crow(e, hh) > n);
                    if (jt == 4) ok = ok && (crow(e, hh) <= n);
                    P[jt][e] = ok ? P[jt][e] : -INFINITY;
                }
            }
            float mx = sink;
#pragma unroll
            for (int jt = 0; jt < 5; ++jt)
#pragma unroll
                for (int e = 0; e < 16; ++e) mx = fmaxf(mx, P[jt][e]);
            mx = fmaxf(mx, shx<32>(mx));
            float sum = 0.f;
#pragma unroll
            for (int jt = 0; jt < 5; ++jt)
#pragma unroll
                for (int e = 0; e < 16; ++e) { const float p = __builtin_amdgcn_exp2f((P[jt][e] - mx) * L2E); P[jt][e] = p; sum += p; }
            sum += shx<32>(sum);
            const float inv = rcpf(sum + __builtin_amdgcn_exp2f((sink - mx) * L2E));
            f32x16 O[2];
#pragma unroll
            for (int e = 0; e < 16; ++e) { O[0][e] = 0.f; O[1][e] = 0.f; }
#pragma unroll
            for (int jt = 0; jt < 5; ++jt) {
                const bool tv = !(blk == 0 && qs + jt < 4);
                if (tv) {
#pragma unroll
                    for (int k2 = 0; k2 < 2; ++k2) {
                        u32x4 pp = {pk2(P[jt][8 * k2], P[jt][8 * k2 + 1]), pk2(P[jt][8 * k2 + 2], P[jt][8 * k2 + 3]), pk2(P[jt][8 * k2 + 4], P[jt][8 * k2 + 5]), pk2(P[jt][8 * k2 + 6], P[jt][8 * k2 + 7])};
                        const bf16x8 pb = __builtin_bit_cast(bf16x8, pp);
#pragma unroll
                        for (int dvb = 0; dvb < 2; ++dvb) {
                            const int dvr = 32 * dvb + n, kx = 32 * qs + 32 * jt + 16 * k2 + 4 * hh, sw = (dvr >> 3) << 2;
                            const LAS unsigned char* vrow = lds + A_VT + dvr * 528;
                            const s16x4 lo = *(const LAS s16x4*)(vrow + ((kx ^ sw) * 2)), hi = *(const LAS s16x4*)(vrow + (((kx + 8) ^ sw) * 2));
                            const bf16x8 va = __builtin_shufflevector(lo, hi, 0, 1, 2, 3, 4, 5, 6, 7);
                            O[dvb] = MFMA32(va, pb, O[dvb]);
                        }
                    }
                }
            }
#pragma unroll
            for (int dvb = 0; dvb < 2; ++dvb)
#pragma unroll
                for (int jj = 0; jj < 4; ++jj) {
                    u32x2 ow = {pk2(O[dvb][4 * jj] * inv, O[dvb][4 * jj + 1] * inv), pk2(O[dvb][4 * jj + 2] * inv, O[dvb][4 * jj + 3] * inv)};
                    *(u32x2*)(qrow + 32 * dvb + 8 * jj + 4 * hh) = ow;
                }
        }
        LDS_WAIT(); __builtin_amdgcn_s_barrier(); asm volatile("" ::: "memory");
        if (un >= NU) break;
        unit = un;
    }
#undef AT_LOADKV
#undef AT_QROW
#undef AT_LOADQ
}

#define XB_TMO      128
#define XB_XCNT(j)  (256  + 64 * (j))
#define XB_XSUB(j)  (1280 + 64 * (j))
#define XB_XGEN(j)  (2304 + 64 * (j))
#define XB_TOP      3328
#define XB_TOPGEN   3392
#define XCD_BAR_WORDS 3456
#define XB_SPIN_CAP (1u << 18)

__device__ __forceinline__ unsigned xb_ld(unsigned* p)              { return __hip_atomic_load(p, __ATOMIC_RELAXED, __HIP_MEMORY_SCOPE_AGENT); }
__device__ __forceinline__ unsigned xb_add(unsigned* p, unsigned v) { return __hip_atomic_fetch_add(p, v, __ATOMIC_RELAXED, __HIP_MEMORY_SCOPE_AGENT); }
__device__ __forceinline__ unsigned xb_xcc_id() { return (unsigned)__builtin_amdgcn_s_getreg((3 << 11) | 20) & 0xFu; }
#define XB_SPIN(cond, bar) do { unsigned _sp = 0; while (cond) { __builtin_amdgcn_s_sleep(1); \
    if ((++_sp & 255u) == 0u) { if (xb_ld(&(bar)[XB_TMO])) break; if (_sp > XB_SPIN_CAP) { atomicAdd(&(bar)[XB_TMO], 1u); break; } } } } while (0)

struct XcdBarrier {
    unsigned* bar; unsigned x;
    volatile LAS unsigned* st;
};

__device__ __forceinline__ XcdBarrier xcd_barrier_post(unsigned* bar, volatile LAS unsigned* st) {
    XcdBarrier b; b.bar = bar; b.x = xb_xcc_id(); b.st = st;
    if (threadIdx.x == 0) (void)xb_add(&bar[XB_XCNT(b.x)], 1u);
    return b;
}
__device__ __forceinline__ void xcd_barrier_complete(unsigned* bar, unsigned x, unsigned& nloc, unsigned& nx) {
    const unsigned G = gridDim.x * gridDim.y * gridDim.z;
    unsigned sum, cnt, mine, sp = 0u;
    for (;;) {
        sum = 0u; cnt = 0u; mine = 0u;
#pragma unroll
        for (unsigned j = 0; j < 16; ++j) { const unsigned c = xb_ld(&bar[XB_XCNT(j)]); sum += c; cnt += (c > 0u) ? 1u : 0u; mine = (j == x) ? c : mine; }
        if (sum == G) break;
        __builtin_amdgcn_s_sleep(1);
        if ((++sp & 255u) == 0u) { if (xb_ld(&bar[XB_TMO])) break; if (sp > XB_SPIN_CAP) { atomicAdd(&bar[XB_TMO], 1u); break; } }
    }
    nloc = mine > 0u ? mine : 1u; nx = cnt > 0u ? cnt : 1u;
}

__device__ __forceinline__ void xcd_barrier(const XcdBarrier& b) {
    asm volatile("s_waitcnt vmcnt(0)" ::: "memory");
    __syncthreads();
    if (threadIdx.x == 0) {
        unsigned* bar = b.bar;
        __builtin_amdgcn_s_waitcnt(0);
        unsigned nloc = b.st[0], nx = b.st[1];
        if (nloc == 0u) { xcd_barrier_complete(bar, b.x, nloc, nx); b.st[0] = nloc; b.st[1] = nx; }
        const unsigned old = xb_add(&bar[XB_XSUB(b.x)], 1u);
        const unsigned gen = old / nloc;
        if (old + 1u == (gen + 1u) * nloc) {
            __builtin_amdgcn_fence(__ATOMIC_RELEASE, "agent");
            asm volatile("s_waitcnt vmcnt(0)" ::: "memory");
            const unsigned og = xb_add(&bar[XB_TOP], 1u);
            const unsigned tg = og / nx;
            if (og + 1u == (tg + 1u) * nx) xb_add(&bar[XB_TOPGEN], 1u);
            else XB_SPIN(xb_ld(&bar[XB_TOPGEN]) == tg, bar);
            __builtin_amdgcn_fence(__ATOMIC_ACQUIRE, "agent");
            xb_add(&bar[XB_XGEN(b.x)], 1u);
            asm volatile("s_waitcnt vmcnt(0)" ::: "memory");
        } else {
            XB_SPIN(xb_ld(&bar[XB_XGEN(b.x)]) == gen, bar);
            __builtin_amdgcn_fence(__ATOMIC_ACQUIRE, "agent");
            asm volatile("s_waitcnt vmcnt(0)" ::: "memory");
        }
    }
    __syncthreads();
}

__device__ __forceinline__ float rstd_of(const float* p) {
    const f32x4 a = *(const f32x4*)p, b = *(const f32x4*)(p + 4), c = *(const f32x4*)(p + 8), d = *(const f32x4*)(p + 12);
    const float s = (((a[0] + a[1]) + (a[2] + a[3])) + ((b[0] + b[1]) + (b[2] + b[3]))) + (((c[0] + c[1]) + (c[2] + c[3])) + ((d[0] + d[1]) + (d[2] + d[3])));
    return rsqrtf(s * (1.f / D) + EPS);
}
__device__ __forceinline__ void compute_rstd(LAS unsigned char* lds, const pg8::StaticOrder& S, const float* ssp) {
    const int tid = fresh_tid(), r = tid & 255, half = tid >> 8;
    LAS float* RS = (LAS float*)(lds + LDS_RS);
    f32x4 p[8][4]; bool ok[8];
#pragma unroll
    for (int k = 0; k < 8; ++k) {
        pg8::Unit u; ok[k] = S.next(2 * k + half, u);
        const float* q = ssp + (size_t)((ok[k] ? u.pm : 0) * 256 + r) * 16;
#pragma unroll
        for (int e = 0; e < 4; ++e) p[k][e] = ok[k] ? *(const f32x4*)(q + 4 * e) : (f32x4){0.f, 0.f, 0.f, 0.f};
    }
#pragma unroll
    for (int k = 0; k < 8; ++k) {
        const f32x4 a = p[k][0], b = p[k][1], c = p[k][2], d = p[k][3];
        const float s = (((a[0] + a[1]) + (a[2] + a[3])) + ((b[0] + b[1]) + (b[2] + b[3]))) + (((c[0] + c[1]) + (c[2] + c[3])) + ((d[0] + d[1]) + (d[2] + d[3])));
        if (ok[k]) RS[(2 * k + half) * 256 + r] = rsqrtf(s * (1.f / D) + EPS);
    }
    __syncthreads();
}
struct Args { const float* in[14]; float* out; unsigned char* ws; };

__global__ void __launch_bounds__(NTHR, 2) hybrid_fwd(Args args) {
    extern __shared__ __attribute__((aligned(16))) unsigned char lds_raw[];
    LAS unsigned char* lds = (LAS unsigned char*)lds_raw;
    cg::grid_group grid = cg::this_grid();
#define GRID_SYNC() xcd_barrier(xbar)
#define CG_SYNC() do { asm volatile("s_waitcnt vmcnt(0)" ::: "memory"); grid.sync(); } while (0)
    const int G = gridDim.x, bx = blockIdx.x, NGW = G * NWAVES;
#define FRESH_IDS const int tid = fresh_tid(), lane = tid & 63, wave = __builtin_amdgcn_readfirstlane(tid >> 6), gw = bx * NWAVES + wave; LAS float* scr = (LAS float*)(lds + wave * 16384); (void)tid; (void)lane; (void)gw; (void)scr
    unsigned char* ws = args.ws;
    const float* x_in = args.in[0]; const float* norm1 = args.in[1]; const float* w_in = args.in[2]; const float* lb_logits = args.in[3];
    const float* hg_norm = args.in[4]; const float* attn_sinks = args.in[5]; const float* w_pa = args.in[6]; const float* w_pb = args.in[7];
    const float* w_o = args.in[8]; const float* norm2 = args.in[9]; const float* w_gate = args.in[10]; const float* w_up = args.in[11];
    const float* w_down = args.in[12]; const float* final_norm = args.in[13];
    float* X = args.out;
    float* SSP = (float*)(ws + WS_SSP); float* LB = (float*)(ws + WS_LB); float* HD = (float*)(ws + WS_HD); float* ROPE = (float*)(ws + WS_ROPE);
    bf16_t* WIN = (bf16_t*)(ws + WS_WIN); bf16_t* WPA = (bf16_t*)(ws + WS_WPA); bf16_t* WPAB = (bf16_t*)(ws + WS_WPAB); (void)WPA; bf16_t* WPB = (bf16_t*)(ws + WS_WPB); bf16_t* WO = (bf16_t*)(ws + WS_WO);
    bf16_t* WGU = (bf16_t*)(ws + WS_WGU); bf16_t* WD = (bf16_t*)(ws + WS_WD);
    bf16_t* XB = (bf16_t*)(ws + WS_XB); bf16_t* QA = (bf16_t*)(ws + WS_QA); _Float16* LOGF = (_Float16*)(ws + WS_LOGF); bf16_t* VH = (bf16_t*)(ws + WS_V);
    bf16_t* GH = (bf16_t*)(ws + WS_GH); bf16_t* AK = (bf16_t*)(ws + WS_AK); bf16_t* AV = (bf16_t*)(ws + WS_AV); float* ST = (float*)(ws + WS_ST);
    unsigned* QCTR = (unsigned*)(ws + WS_BAR) + 3584;
    bf16_t* GATE = (bf16_t*)(ws + WS_GATE); bf16_t* GATEB = (bf16_t*)(ws + WS_LOGF); bf16_t* MIX = (bf16_t*)(ws + WS_MIX); bf16_t* ACT = (bf16_t*)(ws + WS_ACT);

    {
        FRESH_IDS;
        const int gt = bx * NTHR + tid, NGT = G * NTHR;
        { if (gt < 16) QCTR[gt] = 0u; for (int i = gt; i < XCD_BAR_WORDS; i += NGT) ((unsigned*)(ws + WS_BAR))[i] = 0u; if (tid < 64) ((LAS unsigned*)(lds + LDS_XB))[tid] = 0u; }
        for (int i = gt; i < 1024; i += NGT) {
            float l[4], mx = -INFINITY, s = 0.f;
#pragma unroll
            for (int k = 0; k < 4; ++k) { l[k] = lb_logits[k * 1024 + i]; mx = fmaxf(mx, l[k]); }
#pragma unroll
            for (int k = 0; k < 4; ++k) { l[k] = expf(l[k] - mx); s += l[k]; }
            float c = 0.f; const float p0 = l[0] / s;
#pragma unroll
            for (int k = 0; k < 4; ++k) { c += l[k] / s; LB[k * 1024 + i] = c - p0; }
        }
        for (int i = gt; i < SEQ * 8; i += NGT) {
            const int pos = i >> 3, k = i & 7;
            const float inv = (float)exp2(-(double)k * 0.125 * 18.931568569324174);
            const float ang = (float)pos * inv;
            const double a = (double)ang; const double kq = rint(a * 0.15915494309189535); const double r = a - kq * 6.283185307179586;
            ROPE[pos * 16 + k] = cosf((float)r); ROPE[pos * 16 + 8 + k] = sinf((float)r);
        }
        int ioff = 0;
        convert_matrix(w_in, D, NIN, norm1, WIN, 0, scr, gw, NGW, lane, ioff);
        convert_matrix(w_pa, D, D, nullptr, WPAB, 0, scr, gw, NGW, lane, ioff, QP);
        convert_matrix(w_pb, D, D, nullptr, WPAB + D, 0, scr, gw, NGW, lane, ioff, QP);
        convert_matrix(w_o, D, D, nullptr, WO, 0, scr, gw, NGW, lane, ioff);
        convert_matrix(w_gate, D, FF, norm2, WGU, 1, scr, gw, NGW, lane, ioff);
        convert_matrix(w_up, D, FF, norm2, WGU, 2, scr, gw, NGW, lane, ioff);
        convert_matrix(w_down, FF, D, nullptr, WD, 0, scr, gw, NGW, lane, ioff);
        for (int m0 = gw; m0 < T; m0 += 4 * NGW) {
            f32x4 v[4][4];
#pragma unroll
            for (int r = 0; r < 4; ++r)
#pragma unroll
                for (int j = 0; j < 4; ++j) v[r][j] = (m0 + r * NGW < T) ? ((const f32x4*)(x_in + (size_t)(m0 + r * NGW) * D) + lane)[64 * j] : (f32x4){0.f, 0.f, 0.f, 0.f};
#pragma unroll
            for (int r = 0; r < 4; ++r) {
                const int m = m0 + r * NGW; float s = 0.f;
                if (m >= T) break;
                unsigned long long* o8 = (unsigned long long*)(XB + (size_t)m * D) + lane;
#pragma unroll
                for (int j = 0; j < 4; ++j) { const f32x4 q = v[r][j]; s += (q.x * q.x + q.y * q.y) + (q.z * q.z + q.w * q.w); o8[64 * j] = (unsigned long long)pk2(q.x, q.y) | ((unsigned long long)pk2(q.z, q.w) << 32); }
                s = wave_sum(s);
                if (lane < 16) SSP[(size_t)m * 16 + lane] = (lane == 0) ? s : 0.f;
            }
        }
    }
    CG_SYNC();
    const XcdBarrier xbar = xcd_barrier_post((unsigned*)(ws + WS_BAR), (volatile LAS unsigned*)(lds + LDS_XB));

#pragma unroll 1
    for (int l = 0; l < DEPTH; ++l) {
        const float* ss1 = SSP + (size_t)(2 * l) * T * 16; float* ss2 = SSP + (size_t)(2 * l + 1) * T * 16; float* ss3 = SSP + (size_t)(2 * l + 2) * T * 16;
        const LAS float* RS = (const LAS float*)(lds + LDS_RS);
        {
            FRESH_IDS;
            if (l > 0) {
                int ioff = 0;
                convert_matrix(w_down + (size_t)l * FF * D, FF, D, nullptr, WD, 0, scr, gw, NGW, lane, ioff);
                convert_matrix(w_pa + (size_t)l * D * D, D, D, nullptr, WPAB, 0, scr, gw, NGW, lane, ioff, QP);
                convert_matrix(w_pb + (size_t)l * D * D, D, D, nullptr, WPAB + D, 0, scr, gw, NGW, lane, ioff, QP);
                convert_matrix(w_o + (size_t)l * D * D, D, D, nullptr, WO, 0, scr, gw, NGW, lane, ioff);
            }
            pg8::Gemm g{XB, WIN, T, NIN1, D, D}; pg8::StaticOrder S; S.init(T, NIN1, G, bx);
            compute_rstd(lds, S, ss1);
            EpiG1 E{RS, LB + l * 1024, ROPE, QA, LOGF, VH, GH, AK, AV};
            pg8::gemm_phase<EpiG1>(lds, g, S, E);
        }
        GRID_SYNC();
        {
            for (int u = bx; u < BATCH * HGH * NSC; u += G) if ((u % NSC) != NSC - 1) hgrn_unit<false>(lds, u, LOGF, QA, VH, GH, hg_norm + l * 1024, ST, HD);
        }
        GRID_SYNC();
        {
            for (int u = bx; u < BATCH * HGH * NSC; u += G) hgrn_unit<true>(lds, u, LOGF, QA, VH, GH, hg_norm + l * 1024, ST, HD);
            attn_phase(lds, QCTR + l, QA, AK, AV, attn_sinks + l * 16);
        }
        GRID_SYNC();
        {
            pg8::StaticOrder S; S.init(T, D, G, bx);
            compute_rstd(lds, S, ss1);
            {
            { pg8::StaticOrder S2 = S; S2.PAIR = true; pg8::Gemm g{XB, WIN + (size_t)NIN1 * D, T, 2 * D, D, D}; EpiGate E{RS, GATE, GATEB}; pg8::gemm_phase<EpiGate>(lds, g, S2, E); }
            { pg8::Gemm g{QA, WPAB, T, D, 2 * D, QP, QP}; EpiMixK E{GATE, GATEB, MIX}; pg8::gemm_phase<EpiMixK>(lds, g, S, E); }
            }
        }
        GRID_SYNC();
        {
            pg8::Gemm g{MIX, WO, T, D, D, D}; pg8::StaticOrder S; S.init(T, D, G, bx);
            EpiRes E{XB, ss2};
            pg8::gemm_phase<EpiRes>(lds, g, S, E);
        }
        GRID_SYNC();
        {
            FRESH_IDS;
            if (l + 1 < DEPTH) {
                int ioff = 0;
                convert_matrix(w_in + (size_t)(l + 1) * D * NIN, D, NIN, norm1 + (l + 1) * D, WIN, 0, scr, gw, NGW, lane, ioff);
            }
            pg8::Gemm g{XB, WGU, T, NGU, D, D}; pg8::StaticOrder S; S.init(T, NGU, G, bx);
            compute_rstd(lds, S, ss2);
            EpiSwiglu E{RS, ACT};
            pg8::gemm_phase<EpiSwiglu>(lds, g, S, E);
        }
        GRID_SYNC();
        {
            FRESH_IDS;
            if (l + 1 < DEPTH) {
                int ioff = 0;
                convert_matrix(w_gate + (size_t)(l + 1) * D * FF, D, FF, norm2 + (l + 1) * D, WGU, 1, scr, gw, NGW, lane, ioff);
                convert_matrix(w_up + (size_t)(l + 1) * D * FF, D, FF, norm2 + (l + 1) * D, WGU, 2, scr, gw, NGW, lane, ioff);
            }
            __syncthreads();
            pg8::Gemm g{ACT, WD, T, D, FF, FF}; pg8::StaticOrder S; S.init(T, D, G, bx);
            EpiRes E{XB, ss3};
            pg8::gemm_phase<EpiRes>(lds, g, S, E);
        }
        GRID_SYNC();
    }
    {
        FRESH_IDS;
        const float* ssf = SSP + (size_t)8 * T * 16;
        f32x4 g4[4];
#pragma unroll
        for (int j = 0; j < 4; ++j) g4[j] = ((const f32x4*)final_norm + lane)[64 * j];
        for (int m0 = gw; m0 < T; m0 += 4 * NGW) {
            u32x2 v[4][4]; float rstd[4];
#pragma unroll
            for (int r = 0; r < 4; ++r) { const int m = m0 + r * NGW; const bool ok = m < T;
                rstd[r] = ok ? rstd_of(ssf + (size_t)m * 16) : 0.f;
#pragma unroll
                for (int j = 0; j < 4; ++j) v[r][j] = ok ? ((const u32x2*)(XB + (size_t)m * D) + lane)[64 * j] : (u32x2){0u, 0u}; }
#pragma unroll
            for (int r = 0; r < 4; ++r) { const int m = m0 + r * NGW; if (m >= T) break;
                f32x4* orow = (f32x4*)(X + (size_t)m * D) + lane;
#pragma unroll
                for (int j = 0; j < 4; ++j) orow[64 * j] = (f32x4){bf_lo(v[r][j].x), bf_hi(v[r][j].x), bf_lo(v[r][j].y), bf_hi(v[r][j].y)} * rstd[r] * g4[j]; }
        }
    }
}

extern "C" void kernel_launch(void* const* d_in, const int* in_sizes, int n_in, void* d_out, int out_size, void* d_ws, size_t ws_size, hipStream_t stream) {
    static int grid = 0;
    if (grid == 0) {
        if (n_in != 14 || out_size != T * D || ws_size < WS_END) { fprintf(stderr, "kernel_launch: unexpected shapes (n_in %d out %d ws %zu)\n", n_in, out_size, ws_size); grid = -1; return; }
        int dev = 0, cus = 0, per_cu = 0;
        hipGetDevice(&dev);
        hipDeviceGetAttribute(&cus, hipDeviceAttributeMultiprocessorCount, dev);
        if (hipFuncSetAttribute((const void*)hybrid_fwd, hipFuncAttributeMaxDynamicSharedMemorySize, LDS_BYTES) != hipSuccess) { fprintf(stderr, "kernel_launch: hipFuncSetAttribute failed\n"); grid = -1; return; }
        if (hipOccupancyMaxActiveBlocksPerMultiprocessor(&per_cu, (const void*)hybrid_fwd, NTHR, LDS_BYTES) != hipSuccess || per_cu < 1) { fprintf(stderr, "kernel_launch: occupancy query gave %d\n", per_cu); per_cu = 1; }
        (void)hipGetLastError();
        grid = cus * 1;
        if (grid > 256) grid = 256;
    }
    if (grid < 0) return;
    Args a{};
    for (int i = 0; i < 14; ++i) a.in[i] = (const float*)d_in[i];
    a.out = (float*)d_out; a.ws = (unsigned char*)d_ws;
    void* kargs[] = {&a};
    hipError_t e = hipLaunchCooperativeKernel((const void*)hybrid_fwd, dim3(grid), dim3(NTHR), kargs, LDS_BYTES, stream);
    if (e != hipSuccess) fprintf(stderr, "kernel_launch: cooperative launch failed: %s (grid %d)\n", hipGetErrorString(e), grid);
}
```

```cpp
#include <hip/hip_runtime.h>
#include <hip/hip_cooperative_groups.h>
#include <cstdio>
#include <cstdint>
namespace cg = cooperative_groups;

#define LAS __attribute__((address_space(3)))
typedef unsigned short bf16_t;
typedef short bf16x8 __attribute__((ext_vector_type(8)));
typedef short s16x4 __attribute__((ext_vector_type(4)));
typedef float f32x2 __attribute__((ext_vector_type(2)));
typedef float f32x4 __attribute__((ext_vector_type(4)));
typedef float f32x16 __attribute__((ext_vector_type(16)));
typedef unsigned u32x2 __attribute__((ext_vector_type(2)));
typedef unsigned u32x4 __attribute__((ext_vector_type(4)));
typedef __bf16 bf16x2_t __attribute__((ext_vector_type(2)));

constexpr int BATCH = 2, SEQ = 16384, T = BATCH * SEQ, D = 1024, DEPTH = 4;
constexpr int NIN = 7680, NIN1 = 5632, FF = 2816, NGU = 2 * FF;
constexpr int HGH = 8;
constexpr int SC_TOK = 1024, NSC = SEQ / SC_TOK, CH = 64, NCH = SC_TOK / CH;
constexpr float EPS = 1e-6f;
constexpr int NWAVES = 8, NTHR = 512;

constexpr size_t MiB = 1u << 20;
constexpr size_t WS_LB = 1280 * 1024;
constexpr size_t WS_HD = 1536 * 1024;
constexpr size_t WS_ROPE = 2 * MiB;
constexpr size_t WS_WIN = 3 * MiB, WS_WPA = 18 * MiB, WS_WPB = 20 * MiB, WS_WO = 22 * MiB, WS_WGU = 24 * MiB, WS_WD = 35 * MiB;
constexpr size_t WS_XB = 41 * MiB;
constexpr size_t WS_QA = 105 * MiB;
constexpr size_t WS_LOGF = 233 * MiB;
constexpr size_t WS_V = 297 * MiB;
constexpr size_t WS_GH = 361 * MiB;
constexpr size_t WS_AK = 425 * MiB, WS_AV = 441 * MiB;
constexpr size_t WS_ST = 457 * MiB;
constexpr size_t WS_SSP = 473 * MiB;
constexpr size_t WS_END = 492 * MiB;
constexpr int LDS_RS = 131072;
constexpr size_t WS_GATE = WS_V, WS_MIX = WS_GH, WS_ACT = WS_QA;
static_assert(WS_ACT + (size_t)T * FF * 2 <= WS_V, "ACT overlay");

constexpr int LDS_BYTES = 147456 + 256;
constexpr int LDS_XB = 147456;
constexpr size_t WS_BAR = 1792 * 1024;

__device__ __forceinline__ int fresh_tid() { int t = threadIdx.x; asm volatile("" : "+v"(t)); return t; }
namespace pg8 {
constexpr int BM = 256, BK = 64, HALF = 128, HTB = HALF * BK * 2, STAGE_BYTES = 8 * HTB, NXCD = 8, WGM = 4;
__host__ __device__ __forceinline__ int lds_byte(int r, int c) { const int st = (r >> 4) * 2 + (c >> 5), rr = r & 15, cc = c & 31, ob = rr * 64 + cc * 2; return st * 1024 + (ob ^ (((ob >> 9) & 1) << 5)); }
__host__ __device__ __forceinline__ void stage_rc(int b, int& R, int& C) { const int st = b / 1024, sb = b % 1024, swz = sb ^ (((sb >> 9) & 1) << 5); R = (st >> 1) * 16 + swz / 64; C = (st & 1) * 32 + (swz % 64) / 2; }
__host__ __device__ __forceinline__ int perm32(int rho) { const int n = rho >> 4, i = rho & 15; return 8 * (i >> 2) + 4 * n + (i & 3); }
__device__ __forceinline__ void glds16s(const void* sbase, unsigned voff, unsigned lds_dst) {
    unsigned keep;
    asm volatile("s_mov_b32 %0, m0\n\ts_mov_b32 m0, %3\n\ts_nop 0\n\tglobal_load_lds_dwordx4 %1, %2\n\ts_mov_b32 m0, %0" : "=&s"(keep) : "v"(voff), "s"(sbase), "s"(lds_dst) : "memory");
}
struct Unit { int pm, pn, idx; };
struct Gemm { const bf16_t* A; const bf16_t* Bt; int M, N, K, lda; };
struct StaticOrder {
    int nM, nN, nwg, G, c; bool PAIR = false;
    __host__ __device__ void init(int M, int N, int G_, int c_) { nM = M / BM; nN = N / BM; nwg = nM * nN; G = G_; c = c_; }
    __host__ __device__ bool next(int i, Unit& u) const {
        if (PAIR) { if (!next1(i >> 1, u)) return false; u.pn += (i & 1) * nN; return true; }
        return next1(i, u);
    }
    __host__ __device__ bool next1(int i, Unit& u) const {
        const long L = (long)i * G + c; if (L >= nwg) return false;
        int wgid = (int)L; { const int q = nwg / NXCD, r = nwg % NXCD, xcd = wgid % NXCD, off = wgid / NXCD; wgid = (xcd < r ? xcd * (q + 1) : r * (q + 1) + (xcd - r) * q) + off; }
        const int nig = WGM * nN, gid = wgid / nig, fm = gid * WGM, gsz = (nM - fm) < WGM ? (nM - fm) : WGM;
        u.pm = fm + ((wgid % nig) % gsz); u.pn = (wgid % nig) / gsz; u.idx = i; return true;
    }
};
template <class Epi, bool ALIGN_EPI = true>
__device__ __forceinline__ void gemm_phase(LAS unsigned char* lds, const Gemm g, const StaticOrder& S, const Epi& E) {
    const int tid = fresh_tid(), wid = __builtin_amdgcn_readfirstlane(tid >> 6), lane = tid & 63, wr = wid >> 2, wc = wid & 3, fr = lane & 15, fq = lane >> 4;
    const int K = g.K, nt = K / BK, lda = g.lda;
    unsigned voffA[2], voffB[2];
#pragma unroll
    for (int i = 0; i < 2; ++i) { int R, C; stage_rc(tid * 16 + i * 8192, R, C); const int Rb = (R & ~31) + perm32(R & 31);
        voffA[i] = (unsigned)(R * lda + C) * 2u; voffB[i] = (unsigned)(Rb * K + C) * 2u; }
    const size_t kstep = (size_t)(BK * 2);
    const size_t hstepA = (size_t)HALF * lda * 2, hstepB = (size_t)HALF * K * 2;
    const size_t tstepA = 2 * hstepA, tstepB = 2 * hstepB;
    const unsigned ldsw = (unsigned)wid * 1024u, ldsb = (unsigned)(size_t)lds;
    const int aoff = lds_byte(wr * 64 + fr, fq * 8), boff = lds_byte(wc * 32 + fr, fq * 8);
#define PG8_SA(b, h) (((b) * 2 + (h)) * HTB)
#define PG8_SB(b, h) ((4 + (b) * 2 + (h)) * HTB)
#define PG8_STAGE(bufoff, gbase, voff) do { _Pragma("unroll") for (int _i = 0; _i < 2; ++_i) \
        glds16s((const void*)(gbase), (voff)[_i], ldsb + (unsigned)(bufoff) + ldsw + (unsigned)(_i * 8192)); } while (0)
#define PG8_LDA(dst, b, h) do { _Pragma("unroll") for (int m = 0; m < 4; ++m) _Pragma("unroll") for (int k = 0; k < 2; ++k) dst[m][k] = *(const LAS bf16x8*)(lds + PG8_SA(b, h) + aoff + m * 2048 + k * 1024); } while (0)
#define PG8_LDB(dst, b, h) do { _Pragma("unroll") for (int n = 0; n < 2; ++n) _Pragma("unroll") for (int k = 0; k < 2; ++k) dst[n][k] = *(const LAS bf16x8*)(lds + PG8_SB(b, h) + boff + n * 2048 + k * 1024); } while (0)
#define PG8_MMA(ai, bj, At, Bt) do { __builtin_amdgcn_s_setprio(1); _Pragma("unroll") for (int m = 0; m < 4; ++m) _Pragma("unroll") for (int n = 0; n < 2; ++n) _Pragma("unroll") for (int k = 0; k < 2; ++k) \
        acc[ai][bj][m][n] = __builtin_amdgcn_mfma_f32_16x16x32_bf16(Bt[n][k], At[m][k], acc[ai][bj][m][n], 0, 0, 0); __builtin_amdgcn_s_setprio(0); } while (0)
#define PG8_WAIT_V(n) asm volatile("s_waitcnt vmcnt(" #n ")" ::: "memory")
#define PG8_WAIT_L(n) asm volatile("s_waitcnt lgkmcnt(" #n ")" ::: "memory")
#define PG8_BAR __builtin_amdgcn_s_barrier()
#define PG8_SCHED __builtin_amdgcn_sched_barrier(0)
    Unit cur, nxt; int ui = 0;
    if (!S.next(0, cur)) return;
    f32x4 acc[2][2][4][2];
#pragma unroll
    for (int a = 0; a < 2; ++a)
#pragma unroll
        for (int b = 0; b < 2; ++b)
#pragma unroll
            for (int m = 0; m < 4; ++m)
#pragma unroll
                for (int n = 0; n < 2; ++n) acc[a][b][m][n] = (f32x4){0.f, 0.f, 0.f, 0.f};
    bf16x8 At[4][2], B0[2][2], B1[2][2];
    const char* cA = (const char*)g.A + (size_t)cur.pm * tstepA; const char* cB = (const char*)g.Bt + (size_t)cur.pn * tstepB;
    PG8_STAGE(PG8_SB(0, 0), cB, voffB); PG8_STAGE(PG8_SB(0, 1), cB + hstepB, voffB); PG8_STAGE(PG8_SA(0, 0), cA, voffA); PG8_STAGE(PG8_SA(0, 1), cA + hstepA, voffA);
    if (wr == 1) PG8_BAR;
    PG8_WAIT_V(2); PG8_BAR;
    PG8_STAGE(PG8_SB(1, 0), cB + kstep, voffB); PG8_STAGE(PG8_SA(1, 0), cA + kstep, voffA); PG8_STAGE(PG8_SB(1, 1), cB + hstepB + kstep, voffB);
    PG8_WAIT_V(6); PG8_BAR;
    for (;;) {
        const bool has_next = S.next(ui + 1, nxt);
        const char* nA = has_next ? (const char*)g.A + (size_t)nxt.pm * tstepA : cA; const char* nB = has_next ? (const char*)g.Bt + (size_t)nxt.pn * tstepB : cB;
        for (int t = 0; t < nt; t += 2) {
            if constexpr (Epi::HOOK) { if (t == nt / 2) E.hook(acc, cur, wr, wc, fr, fq); }
            const bool last = (t == nt - 2);
            const char* a1 = cA + (size_t)(t + 1) * kstep;
            const char* a2 = last ? nA : cA + (size_t)(t + 2) * kstep; const char* b2 = last ? nB : cB + (size_t)(t + 2) * kstep;
            const char* a3 = a2 + kstep; const char* b3 = b2 + kstep;
            PG8_LDB(B0, 0, 0); PG8_LDB(B1, 0, 1); PG8_SCHED; PG8_LDA(At, 0, 0); PG8_STAGE(PG8_SA(1, 1), a1 + hstepA, voffA);
            PG8_WAIT_V(8); PG8_WAIT_L(0); PG8_BAR; PG8_MMA(0, 0, At, B0); PG8_MMA(0, 1, At, B1); PG8_BAR; PG8_SCHED;
            PG8_LDA(At, 0, 1); PG8_STAGE(PG8_SB(0, 0), b2, voffB); PG8_STAGE(PG8_SB(0, 1), b2 + hstepB, voffB); PG8_STAGE(PG8_SA(0, 0), a2, voffA);
            PG8_WAIT_V(8); PG8_WAIT_L(0); PG8_BAR; PG8_MMA(1, 0, At, B0); PG8_MMA(1, 1, At, B1); PG8_BAR; PG8_SCHED;
            PG8_LDB(B0, 1, 0); PG8_LDB(B1, 1, 1); PG8_SCHED; PG8_LDA(At, 1, 0); PG8_STAGE(PG8_SA(0, 1), a2 + hstepA, voffA);
            PG8_WAIT_V(8); PG8_WAIT_L(0); PG8_BAR; PG8_MMA(0, 0, At, B0); PG8_MMA(0, 1, At, B1); PG8_BAR; PG8_SCHED;
            PG8_LDA(At, 1, 1); PG8_STAGE(PG8_SB(1, 0), b3, voffB); PG8_STAGE(PG8_SB(1, 1), b3 + hstepB, voffB); PG8_STAGE(PG8_SA(1, 0), a3, voffA);
            PG8_WAIT_V(8); PG8_WAIT_L(0); PG8_BAR; PG8_MMA(1, 0, At, B0); PG8_MMA(1, 1, At, B1); PG8_BAR; PG8_SCHED;
        }
        if constexpr (ALIGN_EPI) { if (wr == 0) PG8_BAR; }
        E(acc, cur, wr, wc, fr, fq);
        if (!has_next) break;
#pragma unroll
        for (int a = 0; a < 2; ++a)
#pragma unroll
            for (int b = 0; b < 2; ++b)
#pragma unroll
                for (int m = 0; m < 4; ++m)
#pragma unroll
                    for (int n = 0; n < 2; ++n) acc[a][b][m][n] = (f32x4){0.f, 0.f, 0.f, 0.f};
        cur = nxt; cA = nA; cB = nB; ++ui;
        if constexpr (ALIGN_EPI) { if (wr == 1) PG8_BAR; }
    }
    PG8_WAIT_V(0);
    if constexpr (!ALIGN_EPI) { if (wr == 0) PG8_BAR; }
    PG8_BAR;
#undef PG8_SA
#undef PG8_SB
#undef PG8_STAGE
#undef PG8_LDA
#undef PG8_LDB
#undef PG8_MMA
#undef PG8_WAIT_V
#undef PG8_WAIT_L
#undef PG8_BAR
#undef PG8_SCHED
}
}

__device__ __forceinline__ unsigned pk2(float lo, float hi) { f32x2 v = {lo, hi}; bf16x2_t b = __builtin_convertvector(v, bf16x2_t); return __builtin_bit_cast(unsigned, b); }
__device__ __forceinline__ float bf_lo(unsigned u) { return __uint_as_float(u << 16); }
__device__ __forceinline__ float bf_hi(unsigned u) { return __uint_as_float(u & 0xffff0000u); }
__device__ __forceinline__ float rcpf(float x) { return __builtin_amdgcn_rcpf(x); }
__device__ __forceinline__ float sigmoidf_(float x) { return rcpf(1.f + __expf(-x)); }
__device__ __forceinline__ float siluf_(float x) { return x * sigmoidf_(x); }
template <int MASK> __device__ __forceinline__ float shx(float v) {
    if constexpr (MASK < 32) return __builtin_bit_cast(float, __builtin_amdgcn_ds_swizzle(__builtin_bit_cast(int, v), (MASK << 10) | 0x1f));
    else { int self = (int)__builtin_amdgcn_mbcnt_hi(~0u, __builtin_amdgcn_mbcnt_lo(~0u, 0u)); asm volatile("" : "+v"(self)); return __builtin_bit_cast(float, __builtin_amdgcn_ds_bpermute((self ^ MASK) << 2, __builtin_bit_cast(int, v))); }
}
__device__ __forceinline__ float wave_sum(float v) {
    v += shx<1>(v); v += shx<2>(v); v += shx<4>(v); v += shx<8>(v); v += shx<16>(v); v += shx<32>(v);
    return v;
}
#define LDS_WAIT() asm volatile("s_waitcnt lgkmcnt(0)" ::: "memory")
#define MFMA32(a, b, c) __builtin_amdgcn_mfma_f32_32x32x16_bf16((a), (b), (c), 0, 0, 0)
__device__ __forceinline__ int crow(int e, int hh) { return (e & 3) + 8 * (e >> 2) + 4 * hh; }

using pg8::Unit;
typedef const f32x4 (&AccRef)[2][2][4][2];

#define NT_STORE16(ptr, val) __builtin_nontemporal_store((val), (u32x4*)(void*)(ptr))
__device__ __forceinline__ float fast_sigmoid(float x) { return rcpf(1.f + __builtin_amdgcn_exp2f(x * -1.4426950408889634f)); }
struct EpiG1 {
    static constexpr bool HOOK = false;
    const LAS float* rs; const float* lb; const float* rope; bf16_t* QA; _Float16* LOGF; bf16_t* V; bf16_t* GH; bf16_t* AK; bf16_t* AV;
    template <int KIND> __device__ __forceinline__ void run(AccRef acc, const Unit& u, int wr, int wc, int fr, int fq, bf16_t* dst, int ldd, int cl, float scale) const {
        const int row0 = u.pm * 256 + wr * 64 + fr;
        f32x4 l0[2], l1[2];
        if (KIND == 1) {
#pragma unroll
            for (int bj = 0; bj < 2; ++bj) { l0[bj] = *(const f32x4*)(lb + cl + bj * 128); l1[bj] = *(const f32x4*)(lb + cl + bj * 128 + 4); }
        }
        f32x4 rn[4];
        if (KIND == 3) { const int pos = row0 & (SEQ - 1);
#pragma unroll
            for (int k = 0; k < 4; ++k) rn[k] = *(const f32x4*)(rope + pos * 16 + 4 * k); }
#pragma unroll
        for (int ai = 0; ai < 2; ++ai)
#pragma unroll
            for (int m = 0; m < 4; ++m) {
                const int row = row0 + ai * 128 + m * 16;
                const float rstd = rs[u.idx * 256 + wr * 64 + fr + ai * 128 + m * 16];
                f32x4 c0, c1, s0, s1;
                if (KIND == 3) {
                    c0 = rn[0]; c1 = rn[1]; s0 = rn[2]; s1 = rn[3];
                    if (ai * 4 + m + 1 < 8) { const int gi = ai * 4 + m + 1, pos = (row0 + (gi >> 2) * 128 + (gi & 3) * 16) & (SEQ - 1);
#pragma unroll
                        for (int k = 0; k < 4; ++k) rn[k] = *(const f32x4*)(rope + pos * 16 + 4 * k); }
                }
#pragma unroll
                for (int bj = 0; bj < 2; ++bj) {
                    float v[8];
#pragma unroll
                    for (int e = 0; e < 4; ++e) { v[e] = acc[ai][bj][m][0][e] * rstd; v[4 + e] = acc[ai][bj][m][1][e] * rstd; }
                    const int c = cl + bj * 128;
                    u32x4 w;
                    if (KIND == 0) {
#pragma unroll
                        for (int e = 0; e < 8; ++e) v[e] = v[e] * fast_sigmoid(v[e]);
                    } else if (KIND == 1) {
                        _Float16 h[8];
#pragma unroll
                        for (int e = 0; e < 8; ++e) { const float lbv = e < 4 ? l0[bj][e] : l1[bj][e - 4]; const float f = lbv + (1.f - lbv) * fast_sigmoid(v[e]);
                            h[e] = (_Float16)(__builtin_amdgcn_logf(fmaxf(f, 1e-30f)) * 0.6931471805599453f); }
#pragma unroll
                        for (int e = 0; e < 4; ++e) w[e] = (unsigned)__builtin_bit_cast(unsigned short, h[2 * e]) | ((unsigned)__builtin_bit_cast(unsigned short, h[2 * e + 1]) << 16);
                    } else if (KIND == 3) {
                        if ((wc & 1) == 0) {
#pragma unroll
                            for (int e = 0; e < 8; ++e) {
                                const float cs = e < 4 ? c0[e] : c1[e - 4], sn = e < 4 ? s0[e] : s1[e - 4];
                                const float p = shx<16>(v[e]);
                                const float r = (fq == 0) ? (v[e] * cs - p * sn) : (v[e] * cs + p * sn);
                                v[e] = (fq < 2) ? r : v[e];
                            }
                        }
#pragma unroll
                        for (int e = 0; e < 8; ++e) v[e] *= scale;
                    }
                    if (KIND != 1) { w = (u32x4){pk2(v[0], v[1]), pk2(v[2], v[3]), pk2(v[4], v[5]), pk2(v[6], v[7])}; }
                    NT_STORE16(dst + (size_t)row * ldd + c, w);
                }
            }
    }
    __device__ __forceinline__ void operator()(AccRef acc, const Unit& u, int wr, int wc, int fr, int fq) const {
        const int pn = u.pn;
        const int cl = (pn < 20 ? (pn & 3) * 256 : 0) + wc * 32 + 8 * fq;
        if (pn < 4) run<0>(acc, u, wr, wc, fr, fq, QA, 2048, cl, 1.f);
        else if (pn < 8) run<1>(acc, u, wr, wc, fr, fq, (bf16_t*)LOGF, 1024, cl, 1.f);
        else if (pn < 12) run<2>(acc, u, wr, wc, fr, fq, V, 1024, cl, 1.f);
        else if (pn < 16) run<0>(acc, u, wr, wc, fr, fq, GH, 1024, cl, 1.f);
        else if (pn < 20) run<3>(acc, u, wr, wc, fr, fq, QA + 1024, 2048, cl, 0.125f);
        else if (pn == 20) run<3>(acc, u, wr, wc, fr, fq, AK, 256, cl, 1.f);
        else run<2>(acc, u, wr, wc, fr, fq, AV, 256, cl, 1.f);
    }
};

struct EpiGate {
    static constexpr bool HOOK = false;
    const LAS float* rs; bf16_t* G; bf16_t* G2;
    __device__ __forceinline__ void operator()(AccRef acc, const Unit& u, int wr, int wc, int fr, int fq) const {
        const int row0 = u.pm * 256 + wr * 64 + fr, c0 = (u.pn & 3) * 256 + wc * 32 + 8 * fq; bf16_t* G = u.pn < 4 ? this->G : G2;
#pragma unroll
        for (int ai = 0; ai < 2; ++ai)
#pragma unroll
            for (int m = 0; m < 4; ++m) {
                const int row = row0 + ai * 128 + m * 16;
                const float rstd = rs[u.idx * 256 + wr * 64 + fr + ai * 128 + m * 16];
#pragma unroll
                for (int bj = 0; bj < 2; ++bj) {
                    float v[8];
#pragma unroll
                    for (int e = 0; e < 4; ++e) { v[e] = sigmoidf_(acc[ai][bj][m][0][e] * rstd); v[4 + e] = sigmoidf_(acc[ai][bj][m][1][e] * rstd); }
                    u32x4 w = {pk2(v[0], v[1]), pk2(v[2], v[3]), pk2(v[4], v[5]), pk2(v[6], v[7])};
                    NT_STORE16(G + (size_t)row * 1024 + c0 + bj * 128, w);
                }
            }
    }
};
struct EpiMixK {
    static constexpr bool HOOK = true;
    const bf16_t* GA; const bf16_t* GB; bf16_t* MIX;
    static __device__ __forceinline__ unsigned goff(int gi) { return (unsigned)(((((gi >> 3) & 1) * 128 + ((gi >> 1) & 3) * 16) * 1024 + (gi & 1) * 128) * 2); }
    __device__ __forceinline__ void hook(f32x4 (&acc)[2][2][4][2], const Unit& u, int wr, int wc, int fr, int fq) const {
        int row0 = u.pm * 256 + wr * 64 + fr; const int c0 = u.pn * 256 + wc * 32 + 8 * fq;
        asm volatile("" : "+v"(row0));
        const unsigned vb = ((unsigned)row0 * 1024u + (unsigned)c0) * 2u;
#pragma unroll
        for (int h8 = 0; h8 < 2; ++h8) {
            u32x4 ga[8], gb[8];
#pragma unroll
            for (int k = 0; k < 8; ++k) { ga[k] = *(const u32x4*)((const char*)GA + vb + goff(8 * h8 + k)); gb[k] = *(const u32x4*)((const char*)GB + vb + goff(8 * h8 + k)); }
            asm volatile("" ::: "memory");
#pragma unroll
            for (int k = 0; k < 8; ++k) {
                const int gi = 8 * h8 + k, ai = (gi >> 3) & 1, m = (gi >> 1) & 3, bj = gi & 1;
#pragma unroll
                for (int e = 0; e < 4; ++e) {
                    const float r0 = bf_lo(ga[k][e]) * rcpf(fmaxf(bf_lo(gb[k][e]), 1e-30f)), r1 = bf_hi(ga[k][e]) * rcpf(fmaxf(bf_hi(gb[k][e]), 1e-30f));
                    if (e < 2) { acc[ai][bj][m][0][2 * e] *= r0; acc[ai][bj][m][0][2 * e + 1] *= r1; } else { acc[ai][bj][m][1][2 * e - 4] *= r0; acc[ai][bj][m][1][2 * e - 3] *= r1; }
                }
            }
            asm volatile("" ::: "memory");
        }
    }
    __device__ __forceinline__ void operator()(AccRef acc, const Unit& u, int wr, int wc, int fr, int fq) const {
        const int row0 = u.pm * 256 + wr * 64 + fr, c0 = u.pn * 256 + wc * 32 + 8 * fq;
        const unsigned vb = ((unsigned)row0 * 1024u + (unsigned)c0) * 2u;
#pragma unroll
        for (int q4 = 0; q4 < 2; ++q4) {
            u32x4 gb[8];
#pragma unroll
            for (int k = 0; k < 8; ++k) gb[k] = *(const u32x4*)((const char*)GB + vb + goff(8 * q4 + k));
            asm volatile("" ::: "memory");
#pragma unroll
            for (int k = 0; k < 8; ++k) {
                const int gi = 8 * q4 + k, ai = (gi >> 3) & 1, m = (gi >> 1) & 3, bj = gi & 1;
                u32x4 w;
#pragma unroll
                for (int e = 0; e < 4; ++e) {
                    const float a0 = e < 2 ? acc[ai][bj][m][0][2 * e] : acc[ai][bj][m][1][2 * e - 4], a1 = e < 2 ? acc[ai][bj][m][0][2 * e + 1] : acc[ai][bj][m][1][2 * e - 3];
                    w[e] = pk2(a0 * bf_lo(gb[k][e]), a1 * bf_hi(gb[k][e]));
                }
                NT_STORE16((const char*)MIX + vb + goff(gi), w);
            }
        }
    }
};
struct EpiRes {   static constexpr bool HOOK = false;
    bf16_t* XB; float* sspout;
    __device__ __forceinline__ void operator()(AccRef acc, const Unit& u, int wr, int wc, int fr, int fq) const {
        const int row0 = u.pm * 256 + wr * 64 + fr, c0 = u.pn * 256 + wc * 32 + 8 * fq;
        u32x4 bs[2][4][2];
#pragma unroll
        for (int ai = 0; ai < 2; ++ai)
#pragma unroll
            for (int m = 0; m < 4; ++m)
#pragma unroll
                for (int bj = 0; bj < 2; ++bj) bs[ai][m][bj] = *(const u32x4*)(XB + (size_t)(row0 + ai * 128 + m * 16) * 1024 + c0 + bj * 128);
        asm volatile("" ::: "memory");
#pragma unroll
        for (int ai = 0; ai < 2; ++ai)
#pragma unroll
            for (int m = 0; m < 4; ++m) {
                const int row = row0 + ai * 128 + m * 16; float sq = 0.f;
#pragma unroll
                for (int bj = 0; bj < 2; ++bj) {
                    const size_t off = (size_t)row * 1024 + c0 + bj * 128;
                    const u32x4 b = bs[ai][m][bj];
                    u32x4 w;
#pragma unroll
                    for (int e = 0; e < 4; ++e) {
                        const float a0 = e < 2 ? acc[ai][bj][m][0][2 * e] : acc[ai][bj][m][1][2 * e - 4], a1 = e < 2 ? acc[ai][bj][m][0][2 * e + 1] : acc[ai][bj][m][1][2 * e - 3];
                        w[e] = pk2(bf_lo(b[e]) + a0, bf_hi(b[e]) + a1);
                        const float r0 = bf_lo(w[e]), r1 = bf_hi(w[e]); sq += r0 * r0 + r1 * r1;
                    }
                    *(u32x4*)(XB + off) = w;
                }
                sq += shx<16>(sq); sq += shx<32>(sq);
                if (fq == 0) sspout[(size_t)row * 16 + u.pn * 4 + wc] = sq;
            }
    }
};
struct EpiSwiglu {
    static constexpr bool HOOK = false;
    const LAS float* rs; bf16_t* ACT;
    __device__ __forceinline__ void operator()(AccRef acc, const Unit& u, int wr, int wc, int fr, int fq) const {
        const int row0 = u.pm * 256 + wr * 64 + fr, c0 = u.pn * 128 + wc * 32 + 8 * fq;
#pragma unroll
        for (int ai = 0; ai < 2; ++ai)
#pragma unroll
            for (int m = 0; m < 4; ++m) {
                const int row = row0 + ai * 128 + m * 16;
                const float rstd = rs[u.idx * 256 + wr * 64 + fr + ai * 128 + m * 16];
                float v[8];
#pragma unroll
                for (int e = 0; e < 4; ++e) { v[e] = siluf_(acc[ai][0][m][0][e] * rstd) * (acc[ai][1][m][0][e] * rstd); v[4 + e] = siluf_(acc[ai][0][m][1][e] * rstd) * (acc[ai][1][m][1][e] * rstd); }
                u32x4 w = {pk2(v[0], v[1]), pk2(v[2], v[3]), pk2(v[4], v[5]), pk2(v[6], v[7])};
                NT_STORE16(ACT + (size_t)row * FF + c0, w);
            }
    }
};

#define CV_LOAD(dst, k0_, n0_) do { _Pragma("unroll") for (int i = 0; i < 32; ++i) dst[i] = W[(size_t)((k0_) + 2 * i + (lane >> 5)) * N + (n0_) + (lane & 31)]; } while (0)
__device__ __forceinline__ void convert_matrix(const float* W, int K, int N, const float* gain, bf16_t* WT, int mode, LAS float* scr, int gw, int NGW, int lane, int& ioff, int ldt = 0) {
    if (ldt == 0) ldt = K;
    const int nblk = N / 32, nitems = (K / 64) * nblk;
    int it0 = (gw - ioff) % NGW; if (it0 < 0) it0 += NGW;
    ioff = (ioff + nitems) % NGW;
    float wn[32];
    if (it0 < nitems) CV_LOAD(wn, (it0 / nblk) * 64, (it0 % nblk) * 32);
    const int c = lane & 7;
    for (int it = it0; it < nitems; it += NGW) {
        const int kb = it / nblk, nb = it % nblk, n0 = nb * 32, k0 = kb * 64;
        const int dst = mode == 0 ? n0 : 256 * (n0 / 128) + (n0 % 128) + (mode == 2 ? 128 : 0);
        f32x4 g0 = {1.f, 1.f, 1.f, 1.f}, g1 = {1.f, 1.f, 1.f, 1.f};
        if (gain) { g0 = *(const f32x4*)(gain + k0 + 8 * c); g1 = *(const f32x4*)(gain + k0 + 8 * c + 4); }
#pragma unroll
        for (int i = 0; i < 32; ++i) scr[(2 * i + (lane >> 5)) * 33 + (lane & 31)] = wn[i];
        const int itn = it + NGW;
        if (itn < nitems) CV_LOAD(wn, (itn / nblk) * 64, (itn % nblk) * 32);
        LDS_WAIT(); asm volatile("" ::: "memory");
#pragma unroll
        for (int j = 0; j < 4; ++j) { const int n = (lane >> 3) + 8 * j; const LAS float* s = scr + (8 * c) * 33 + n;
            u32x4 o = {pk2(s[0 * 33] * g0[0], s[1 * 33] * g0[1]), pk2(s[2 * 33] * g0[2], s[3 * 33] * g0[3]), pk2(s[4 * 33] * g1[0], s[5 * 33] * g1[1]), pk2(s[6 * 33] * g1[2], s[7 * 33] * g1[3])};
            *(u32x4*)(WT + (size_t)(dst + n) * ldt + k0 + 8 * c) = o; }
        LDS_WAIT(); asm volatile("" ::: "memory");
    }
}
#undef CV_LOAD

constexpr int H_QT = 0, H_KC = 17408, H_KCT = 34816, H_VT = 53248, H_SBT = 71680, H_OST = 106496, H_ER = 140288, H_PFX = 140800;
constexpr int H_HGW = H_PFX + 4096;
static_assert(H_HGW + 512 <= LDS_XB, "hgrn lds");
template <bool OUT>
__device__ __forceinline__ void hgrn_unit(LAS unsigned char* lds, int unit, const _Float16* LOGF, bf16_t* QA, const bf16_t* V, const bf16_t* GH, const float* hgw  ,
                                          float* ST, float* HD) {
    const int tid = fresh_tid(), w = __builtin_amdgcn_readfirstlane(tid >> 6), lane = tid & 63, n = lane & 31, hh = lane >> 5;
    const int bh = unit / NSC, sc = unit % NSC, b = bh / HGH, h = bh % HGH;
    const int cb = w & 3, dvb0 = 2 * (w >> 2);
    const int tbO = w >> 2, dvbO = w & 3;
    LAS float* ER = (LAS float*)(lds + H_ER); LAS float* PFX = (LAS float*)(lds + H_PFX);
    f32x16 S[2];
#pragma unroll
    for (int e = 0; e < 16; ++e) { S[0][e] = 0.f; S[1][e] = 0.f; }
    if (OUT && sc > 0) {
        f32x4 wg[4];
#pragma unroll
        for (int jj = 0; jj < 4; ++jj) wg[jj] = (f32x4){1.f, 1.f, 1.f, 1.f};
        f32x16 L0[2], L1[2], L2[2]; f32x4 d0[4], d1[4], d2[4];
#define HG_LDSTATE(L_, d_, jj_) do { const bool ok_ = (jj_) >= 0; const int uj_ = bh * NSC + (ok_ ? (jj_) : 0); const unsigned* Lp_ = (const unsigned*)ST + (size_t)uj_ * 8192 + (size_t)(w * 16) * 64 + lane; \
            _Pragma("unroll") for (int tl = 0; tl < 2; ++tl) _Pragma("unroll") for (int e = 0; e < 8; ++e) { const unsigned pw_ = ok_ ? Lp_[(tl * 8 + e) * 64] : 0u; L_[tl][2 * e] = bf_lo(pw_); L_[tl][2 * e + 1] = bf_hi(pw_); } \
            _Pragma("unroll") for (int q = 0; q < 4; ++q) d_[q] = ok_ ? *(const f32x4*)(HD + (size_t)uj_ * 128 + 32 * cb + 8 * q + 4 * hh) : (f32x4){1.f, 1.f, 1.f, 1.f}; } while (0)
#define HG_ACC(L_, d_) do { _Pragma("unroll") for (int tl = 0; tl < 2; ++tl) _Pragma("unroll") for (int e = 0; e < 16; ++e) S[tl][e] += wg[e >> 2][e & 3] * L_[tl][e]; \
            _Pragma("unroll") for (int q = 0; q < 4; ++q) wg[q] *= d_[q]; } while (0)
        for (int j = sc - 1; j >= 0; j -= 3) {
            HG_LDSTATE(L0, d0, j); HG_LDSTATE(L1, d1, j - 1); HG_LDSTATE(L2, d2, j - 2);
            HG_ACC(L0, d0); HG_ACC(L1, d1); HG_ACC(L2, d2);
        }
#undef HG_ACC
#undef HG_LDSTATE
    }
    float dlog0 = 0.f, dlog1 = 0.f;
    const int c0 = 2 * lane;
    if (OUT && tid < 128) *(LAS float*)(lds + H_HGW + tid * 4) = hgw[h * 128 + tid];
    const size_t tok_sc = (size_t)b * SEQ + (size_t)sc * SC_TOK;
    unsigned gq[8], qq[8], vq[8];
#define HG_LOAD(chn) do { const size_t t0_ = tok_sc + (size_t)(chn) * CH; _Pragma("unroll") for (int i = 0; i < 8; ++i) { const size_t row_ = t0_ + 8 * w + i; \
        gq[i] = *(const unsigned*)(LOGF + row_ * 1024 + h * 128 + c0); vq[i] = *(const unsigned*)(V + row_ * 1024 + h * 128 + c0); \
        if (OUT) qq[i] = *(const unsigned*)(QA + row_ * 2048 + h * 128 + c0); } } while (0)
#pragma unroll 1
    for (int ch = 0; ch < NCH; ++ch) {
        const size_t tok0 = tok_sc + (size_t)ch * CH;
        if (ch == 0) HG_LOAD(0);
        float b0[8], b1[8]; float a0 = 0.f, a1 = 0.f;
#pragma unroll
        for (int i = 0; i < 8; ++i) {
            const float g0 = (float)__builtin_bit_cast(_Float16, (unsigned short)(gq[i] & 0xffffu)), g1 = (float)__builtin_bit_cast(_Float16, (unsigned short)(gq[i] >> 16));
            a0 += g0; a1 += g1; b0[i] = a0; b1[i] = a1;
        }
        *(LAS f32x2*)(PFX + w * 128 + c0) = (f32x2){a0, a1};
        LDS_WAIT(); __builtin_amdgcn_s_barrier(); asm volatile("" ::: "memory");
        float p0 = 0.f, p1 = 0.f, t0 = 0.f, t1 = 0.f;
#pragma unroll
        for (int ww = 0; ww < 8; ++ww) { const f32x2 x = *(const LAS f32x2*)(PFX + ww * 128 + c0); t0 += x.x; t1 += x.y; if (ww < w) { p0 += x.x; p1 += x.y; } }
        const float r0 = 0.5f * t0, r1 = 0.5f * t1;
        if (w == 0) *(LAS f32x2*)(ER + c0) = (f32x2){__expf(r0), __expf(r1)};
        dlog0 += t0; dlog1 += t1;
        float kc0[8], kc1[8];
#pragma unroll
        for (int i = 0; i < 8; ++i) {
            const float g0 = (float)__builtin_bit_cast(_Float16, (unsigned short)(gq[i] & 0xffffu)), g1 = (float)__builtin_bit_cast(_Float16, (unsigned short)(gq[i] >> 16));
            const float bt0 = p0 + b0[i], bt1 = p1 + b1[i];
            kc0[i] = (1.f - __expf(g0)) * __expf(r0 - bt0); kc1[i] = (1.f - __expf(g1)) * __expf(r1 - bt1);
            if (OUT) {
                const float q0 = bf_lo(qq[i]) * __expf(bt0 - r0), q1 = bf_hi(qq[i]) * __expf(bt1 - r1);
                const int t = 8 * w + i;
                *(LAS unsigned*)(lds + H_QT + t * 272 + c0 * 2) = pk2(q0, q1);
                *(LAS unsigned*)(lds + H_KC + t * 272 + c0 * 2) = pk2(kc0[i], kc1[i]);
            }
        }
        {
            u32x4 k0v = {pk2(kc0[0], kc0[1]), pk2(kc0[2], kc0[3]), pk2(kc0[4], kc0[5]), pk2(kc0[6], kc0[7])};
            u32x4 k1v = {pk2(kc1[0], kc1[1]), pk2(kc1[2], kc1[3]), pk2(kc1[4], kc1[5]), pk2(kc1[6], kc1[7])};
            *(LAS u32x4*)(lds + H_KCT + c0 * 144 + 16 * w) = k0v; *(LAS u32x4*)(lds + H_KCT + (c0 + 1) * 144 + 16 * w) = k1v;
            u32x4 v0v, v1v;
#pragma unroll
            for (int i = 0; i < 4; ++i) { v0v[i] = (vq[2 * i] & 0xffffu) | (vq[2 * i + 1] << 16); v1v[i] = (vq[2 * i] >> 16) | (vq[2 * i + 1] & 0xffff0000u); }
            *(LAS u32x4*)(lds + H_VT + c0 * 144 + 16 * w) = v0v; *(LAS u32x4*)(lds + H_VT + (c0 + 1) * 144 + 16 * w) = v1v;
        }
        LDS_WAIT(); __builtin_amdgcn_s_barrier(); asm volatile("" ::: "memory");
        if (ch + 1 < NCH) HG_LOAD(ch + 1);
        u32x4 gg0 = {0u, 0u, 0u, 0u}, gg1 = {0u, 0u, 0u, 0u};
        if (OUT) { const size_t grow = tok0 + (tid >> 3); gg0 = *(const u32x4*)(GH + grow * 1024 + h * 128 + 16 * (tid & 7)); gg1 = *(const u32x4*)(GH + grow * 1024 + h * 128 + 16 * (tid & 7) + 8); }
        f32x4 er[4];
#pragma unroll
        for (int jj = 0; jj < 4; ++jj) er[jj] = *(const LAS f32x4*)(ER + 32 * cb + 8 * jj + 4 * hh);
        asm volatile("" ::: "memory");
#pragma unroll
        for (int tl = 0; tl < 2; ++tl) {
#pragma unroll
            for (int e = 0; e < 16; ++e) S[tl][e] *= er[e >> 2][e & 3];
            if (OUT) {
#pragma unroll
                for (int jj = 0; jj < 4; ++jj) { u32x2 pw = {pk2(S[tl][4 * jj], S[tl][4 * jj + 1]), pk2(S[tl][4 * jj + 2], S[tl][4 * jj + 3])};
                    *(LAS u32x2*)(lds + H_SBT + (32 * (dvb0 + tl) + n) * 272 + (32 * cb + 8 * jj + 4 * hh) * 2) = pw; }
            }
        }
        if (OUT) {
            LDS_WAIT(); __builtin_amdgcn_s_barrier(); asm volatile("" ::: "memory");
            bf16x8 qf[8];
#pragma unroll
            for (int ks = 0; ks < 8; ++ks) qf[ks] = *(const LAS bf16x8*)(lds + H_QT + (32 * tbO + n) * 272 + (16 * ks + 8 * hh) * 2);
            f32x16 O, O2, O3;
#pragma unroll
            for (int e = 0; e < 16; ++e) { O[e] = 0.f; O2[e] = 0.f; O3[e] = 0.f; }
#pragma unroll
            for (int sb = 0; sb < 2; ++sb) {
                if (sb <= tbO) {
                    f32x16 P;
#pragma unroll
                    for (int e = 0; e < 16; ++e) P[e] = 0.f;
#pragma unroll
                    for (int ks = 0; ks < 8; ++ks) { const bf16x8 kf = *(const LAS bf16x8*)(lds + H_KC + (32 * sb + n) * 272 + (16 * ks + 8 * hh) * 2); P = MFMA32(kf, qf[ks], P); }
                    if (sb == tbO) {
#pragma unroll
                        for (int e = 0; e < 16; ++e) P[e] = (crow(e, hh) <= n) ? P[e] : 0.f;
                    }
#pragma unroll
                    for (int k2 = 0; k2 < 2; ++k2) {
                        u32x4 pp = {pk2(P[8 * k2], P[8 * k2 + 1]), pk2(P[8 * k2 + 2], P[8 * k2 + 3]), pk2(P[8 * k2 + 4], P[8 * k2 + 5]), pk2(P[8 * k2 + 6], P[8 * k2 + 7])};
                        const bf16x8 pa = __builtin_bit_cast(bf16x8, pp);
                        const LAS unsigned char* vp = lds + H_VT + (32 * dvbO + n) * 144 + (32 * sb + 16 * k2 + 4 * hh) * 2;
                        const s16x4 lo = *(const LAS s16x4*)vp, hi = *(const LAS s16x4*)(vp + 16);
                        const bf16x8 vb = __builtin_shufflevector(lo, hi, 0, 1, 2, 3, 4, 5, 6, 7);
                        O = MFMA32(pa, vb, O);
                    }
                }
            }
#pragma unroll
            for (int ks = 0; ks < 8; ++ks) { const bf16x8 sf = *(const LAS bf16x8*)(lds + H_SBT + (32 * dvbO + n) * 272 + (16 * ks + 8 * hh) * 2); if (ks & 1) O3 = MFMA32(qf[ks], sf, O3); else O2 = MFMA32(qf[ks], sf, O2); }
#pragma unroll
            for (int e = 0; e < 16; ++e) *(LAS float*)(lds + H_OST + (32 * tbO + crow(e, hh)) * 528 + (32 * dvbO + n) * 4) = O[e] + (O2[e] + O3[e]);
        }
#pragma unroll
        for (int ks = 0; ks < 4; ++ks) {
            const bf16x8 a = *(const LAS bf16x8*)(lds + H_KCT + (32 * cb + n) * 144 + (16 * ks + 8 * hh) * 2);
#pragma unroll
            for (int tl = 0; tl < 2; ++tl) { const bf16x8 bb = *(const LAS bf16x8*)(lds + H_VT + (32 * (dvb0 + tl) + n) * 144 + (16 * ks + 8 * hh) * 2); S[tl] = MFMA32(a, bb, S[tl]); }
        }
        {
            f32x4 er2[4];
#pragma unroll
            for (int jj = 0; jj < 4; ++jj) er2[jj] = *(const LAS f32x4*)(ER + 32 * cb + 8 * jj + 4 * hh);
#pragma unroll
            for (int tl = 0; tl < 2; ++tl)
#pragma unroll
                for (int e = 0; e < 16; ++e) S[tl][e] *= er2[e >> 2][e & 3];
        }
        if (OUT) {
            LDS_WAIT(); __builtin_amdgcn_s_barrier(); asm volatile("" ::: "memory");
            const int t = tid >> 3, cq = tid & 7;
            const size_t row = tok0 + t;
            const u32x4 g0 = gg0, g1 = gg1;
            f32x4 o[4]; float sq = 0.f;
#pragma unroll
            for (int i = 0; i < 4; ++i) { o[i] = *(const LAS f32x4*)(lds + H_OST + t * 528 + (16 * cq + 4 * i) * 4); sq += (o[i][0] * o[i][0] + o[i][1] * o[i][1]) + (o[i][2] * o[i][2] + o[i][3] * o[i][3]); }
            sq += shx<1>(sq); sq += shx<2>(sq); sq += shx<4>(sq);
            const float rs = rsqrtf(sq * (1.f / 128.f) + EPS);
            float r[16];
#pragma unroll
            for (int i = 0; i < 4; ++i) { const f32x4 wv = *(const LAS f32x4*)(lds + H_HGW + (16 * cq + 4 * i) * 4);
#pragma unroll
                for (int e = 0; e < 4; ++e) r[4 * i + e] = o[i][e] * rs * wv[e]; }
            u32x4 w0, w1;
#pragma unroll
            for (int i = 0; i < 4; ++i) { w0[i] = pk2(r[2 * i] * bf_lo(g0[i]), r[2 * i + 1] * bf_hi(g0[i])); w1[i] = pk2(r[8 + 2 * i] * bf_lo(g1[i]), r[8 + 2 * i + 1] * bf_hi(g1[i])); }
            bf16_t* op = QA + row * 2048 + h * 128 + 16 * cq;
            *(u32x4*)op = w0; *(u32x4*)(op + 8) = w1;
        }
    }
    if (!OUT) {
        unsigned* Lp = (unsigned*)ST + (size_t)unit * 8192 + (size_t)(w * 16) * 64 + lane;
#pragma unroll
        for (int tl = 0; tl < 2; ++tl)
#pragma unroll
            for (int e = 0; e < 8; ++e) Lp[(tl * 8 + e) * 64] = pk2(S[tl][2 * e], S[tl][2 * e + 1]);
        if (w == 0) *(f32x2*)(HD + (size_t)unit * 128 + c0) = (f32x2){__expf(dlog0), __expf(dlog1)};
    }
    LDS_WAIT(); __builtin_amdgcn_s_barrier(); asm volatile("" ::: "memory");
}

constexpr int A_KS = 0, A_VT = 36864;
__device__ __forceinline__ void attn_phase(LAS unsigned char* lds, unsigned* qctr, bf16_t* QA, const bf16_t* AK, const bf16_t* AV, const float* sinks  ) {
    const int tid = fresh_tid(), w = __builtin_amdgcn_readfirstlane(tid >> 6), lane = tid & 63, n = lane & 31, hh = lane >> 5;
    constexpr int NU = BATCH * 128 * 4;
    constexpr float L2E = 1.4426950408889634f;
    const int g = w >> 1;
    volatile LAS unsigned* qw = (volatile LAS unsigned*)(lds + LDS_XB + 128);
    if (tid == 0) qw[0] = __hip_atomic_fetch_add(qctr, 1u, __ATOMIC_RELAXED, __HIP_MEMORY_SCOPE_AGENT);
    __syncthreads();
    int unit = (int)qw[0];
    __syncthreads();
    if (unit >= NU) return;
    u32x4 kr[4], vr[4]; bf16x8 qn[4];
#pragma unroll
    for (int i = 0; i < 4; ++i) { kr[i] = (u32x4){0u, 0u, 0u, 0u}; vr[i] = (u32x4){0u, 0u, 0u, 0u}; }
#define AT_LOADKV(un_) do { const int kvh_ = (un_) & 3, blk_ = ((un_) >> 2) & 127, b_ = (un_) >> 9; const long tb_ = (long)b_ * SEQ + (long)blk_ * 128; const int k0_ = (blk_ == 0) ? 128 : 0; \
        _Pragma("unroll") for (int i = 0; i < 4; ++i) { const int ci = tid + 512 * i; { const int key = ci >> 3, part = ci & 7; if (key >= k0_) kr[i] = *(const u32x4*)(AK + (size_t)(tb_ - 128 + key) * 256 + kvh_ * 64 + part * 8); } \
            { const int key = ci >> 3, part = ci & 7; if (key >= k0_) vr[i] = *(const u32x4*)(AV + (size_t)(tb_ - 128 + key) * 256 + kvh_ * 64 + part * 8); } } } while (0)
#define AT_QROW(un_, qs_) (QA + (size_t)((long)((un_) >> 9) * SEQ + (long)(((un_) >> 2) & 127) * 128 + 32 * (qs_) + n) * 2048 + 1024 + (((un_) & 3) * 4 + g) * 64)
#define AT_LOADQ(un_, qs_) do { const bf16_t* qr_ = AT_QROW(un_, qs_); _Pragma("unroll") for (int ks = 0; ks < 4; ++ks) qn[ks] = *(const bf16x8*)(qr_ + 16 * ks + 8 * hh); } while (0)
    AT_LOADKV(unit); AT_LOADQ(unit, 2 * (w & 1));
    float sinkn = sinks[(unit & 3) * 4 + g];
    unsigned pend = 0u;
    if (tid == 0) pend = __hip_atomic_fetch_add(qctr, 1u, __ATOMIC_RELAXED, __HIP_MEMORY_SCOPE_AGENT);
#pragma unroll 1
    for (;;) {
        const int kvh = unit & 3, blk = (unit >> 2) & 127;
        if (tid == 0) { qw[0] = pend; pend = __hip_atomic_fetch_add(qctr, 1u, __ATOMIC_RELAXED, __HIP_MEMORY_SCOPE_AGENT); }
        const int kk0 = (blk == 0) ? 128 : 0;
#pragma unroll
        for (int i = 0; i < 4; ++i) {
            const int ci = tid + 512 * i;
            { const int key = ci >> 3, part = ci & 7; if (key >= kk0) *(LAS u32x4*)(lds + A_KS + key * 144 + part * 16) = kr[i]; }
            { const int key = ci >> 3, part = ci & 7, ksw = key ^ (part << 2); if (key >= kk0) {
#pragma unroll
                for (int e = 0; e < 4; ++e) { *(LAS unsigned short*)(lds + A_VT + (part * 8 + 2 * e) * 528 + ksw * 2) = (unsigned short)(vr[i][e] & 0xffffu); *(LAS unsigned short*)(lds + A_VT + (part * 8 + 2 * e + 1) * 528 + ksw * 2) = (unsigned short)(vr[i][e] >> 16); } } }
        }
        LDS_WAIT(); __builtin_amdgcn_s_barrier(); asm volatile("" ::: "memory");
        const int un = (int)qw[0];
        const float sink = sinkn;
        if (un < NU) { AT_LOADKV(un); sinkn = sinks[(un & 3) * 4 + g]; }
        const int hq = kvh * 4 + g;
#pragma unroll 1
        for (int tk = 0; tk < 2; ++tk) {
            const int qs = 2 * (w & 1) + tk;
            bf16_t* qrow = AT_QROW(unit, qs);
            bf16x8 qf[4];
#pragma unroll
            for (int ks = 0; ks < 4; ++ks) qf[ks] = qn[ks];
            if (tk == 0) AT_LOADQ(unit, qs + 1); else if (un < NU) AT_LOADQ(un, 2 * (w & 1));
            f32x16 P[5];
#pragma unroll
            for (int jt = 0; jt < 5; ++jt) {
                const bool tv = !(blk == 0 && qs + jt < 4);
#pragma unroll
                for (int e = 0; e < 16; ++e) P[jt][e] = 0.f;
                if (tv) {
#pragma unroll
                    for (int ks = 0; ks < 4; ++ks) { const bf16x8 kf = *(const LAS bf16x8*)(lds + A_KS + (32 * qs + 32 * jt + n) * 144 + (16 * ks + 8 * hh) * 2); P[jt] = MFMA32(kf, qf[ks], P[jt]); }
                }
#pragma unroll
                for (int e = 0; e < 16; ++e) {
                    bool ok = tv;
                    if (jt == 0) ok = ok && (crow(e, hh) > n);
                    if (jt == 4) ok = ok && (crow(e, hh) <= n);
                    P[jt][e] = ok ? P[jt][e] : -INFINITY;
                }
            }
            float mx = sink;
#pragma unroll
            for (int jt = 0; jt < 5; ++jt)
#pragma unroll
                for (int e = 0; e < 16; ++e) mx = fmaxf(mx, P[jt][e]);
            mx = fmaxf(mx, shx<32>(mx));
            float sum = 0.f;
#pragma unroll
            for (int jt = 0; jt < 5; ++jt)
#pragma unroll
                for (int e = 0; e < 16; ++e) { const float p = __builtin_amdgcn_exp2f((P[jt][e] - mx) * L2E); P[jt][e] = p; sum += p; }
            sum += shx<32>(sum);
            const float inv = rcpf(sum + __builtin_amdgcn_exp2f((sink - mx) * L2E));
            f32x16 O[2];
#pragma unroll
            for (int e = 0; e < 16; ++e) { O[0][e] = 0.f; O[1][e] = 0.f; }
#pragma unroll
            for (int jt = 0; jt < 5; ++jt) {
                const bool tv = !(blk == 0 && qs + jt < 4);
                if (tv) {
#pragma unroll
                    for (int k2 = 0; k2 < 2; ++k2) {
                        u32x4 pp = {pk2(P[jt][8 * k2], P[jt][8 * k2 + 1]), pk2(P[jt][8 * k2 + 2], P[jt][8 * k2 + 3]), pk2(P[jt][8 * k2 + 4], P[jt][8 * k2 + 5]), pk2(P[jt][8 * k2 + 6], P[jt][8 * k2 + 7])};
                        const bf16x8 pb = __builtin_bit_cast(bf16x8, pp);
#pragma unroll
                        for (int dvb = 0; dvb < 2; ++dvb) {
                            const int dvr = 32 * dvb + n, kx = 32 * qs + 32 * jt + 16 * k2 + 4 * hh, sw = (dvr >> 3) << 2;
                            const LAS unsigned char* vrow = lds + A_VT + dvr * 528;
                            const s16x4 lo = *(const LAS s16x4*)(vrow + ((kx ^ sw) * 2)), hi = *(const LAS s16x4*)(vrow + (((kx + 8) ^ sw) * 2));
                            const bf16x8 va = __builtin_shufflevector(lo, hi, 0, 1, 2, 3, 4, 5, 6, 7);
                            O[dvb] = MFMA32(va, pb, O[dvb]);
                        }
                    }
                }
            }
#pragma unroll
            for (int dvb = 0; dvb < 2; ++dvb)
#pragma unroll
                for (int jj = 0; jj < 4; ++jj) {
                    u32x2 ow = {pk2(O[dvb][4 * jj] * inv, O[dvb][4 * jj + 1] * inv), pk2(O[dvb][4 * jj + 2] * inv, O[dvb][4 * jj + 3] * inv)};
                    *(u32x2*)(qrow + 32 * dvb + 8 * jj + 4 * hh) = ow;
                }
        }
        LDS_WAIT(); __builtin_amdgcn_s_barrier(); asm volatile("" ::: "memory");
        if (un >= NU) break;
        unit = un;
    }
#undef AT_LOADKV
#undef AT_QROW
#undef AT_LOADQ
}

#define XB_TMO      128
#define XB_XCNT(j)  (256  + 64 * (j))
#define XB_XSUB(j)  (1280 + 64 * (j))
#define XB_XGEN(j)  (2304 + 64 * (j))
#define XB_TOP      3328
#define XB_TOPGEN   3392
#define XCD_BAR_WORDS 3456
#define XB_SPIN_CAP (1u << 18)

__device__ __forceinline__ unsigned xb_ld(unsigned* p)              { return __hip_atomic_load(p, __ATOMIC_RELAXED, __HIP_MEMORY_SCOPE_AGENT); }
__device__ __forceinline__ unsigned xb_add(unsigned* p, unsigned v) { return __hip_atomic_fetch_add(p, v, __ATOMIC_RELAXED, __HIP_MEMORY_SCOPE_AGENT); }
__device__ __forceinline__ unsigned xb_xcc_id() { return (unsigned)__builtin_amdgcn_s_getreg((3 << 11) | 20) & 0xFu; }
#define XB_SPIN(cond, bar) do { unsigned _sp = 0; while (cond) { __builtin_amdgcn_s_sleep(1); \
    if ((++_sp & 255u) == 0u) { if (xb_ld(&(bar)[XB_TMO])) break; if (_sp > XB_SPIN_CAP) { atomicAdd(&(bar)[XB_TMO], 1u); break; } } } } while (0)

struct XcdBarrier {
    unsigned* bar; unsigned x;
    volatile LAS unsigned* st;
};

__device__ __forceinline__ XcdBarrier xcd_barrier_post(unsigned* bar, volatile LAS unsigned* st) {
    XcdBarrier b; b.bar = bar; b.x = xb_xcc_id(); b.st = st;
    if (threadIdx.x == 0) (void)xb_add(&bar[XB_XCNT(b.x)], 1u);
    return b;
}
__device__ __forceinline__ void xcd_barrier_complete(unsigned* bar, unsigned x, unsigned& nloc, unsigned& nx) {
    const unsigned G = gridDim.x * gridDim.y * gridDim.z;
    unsigned sum, cnt, mine, sp = 0u;
    for (;;) {
        sum = 0u; cnt = 0u; mine = 0u;
#pragma unroll
        for (unsigned j = 0; j < 16; ++j) { const unsigned c = xb_ld(&bar[XB_XCNT(j)]); sum += c; cnt += (c > 0u) ? 1u : 0u; mine = (j == x) ? c : mine; }
        if (sum == G) break;
        __builtin_amdgcn_s_sleep(1);
        if ((++sp & 255u) == 0u) { if (xb_ld(&bar[XB_TMO])) break; if (sp > XB_SPIN_CAP) { atomicAdd(&bar[XB_TMO], 1u); break; } }
    }
    nloc = mine > 0u ? mine : 1u; nx = cnt > 0u ? cnt : 1u;
}

__device__ __forceinline__ void xcd_barrier(const XcdBarrier& b) {
    asm volatile("s_waitcnt vmcnt(0)" ::: "memory");
    __syncthreads();
    if (threadIdx.x == 0) {
        unsigned* bar = b.bar;
        __builtin_amdgcn_s_waitcnt(0);
        unsigned nloc = b.st[0], nx = b.st[1];
        if (nloc == 0u) { xcd_barrier_complete(bar, b.x, nloc, nx); b.st[0] = nloc; b.st[1] = nx; }
        const unsigned old = xb_add(&bar[XB_XSUB(b.x)], 1u);
        const unsigned gen = old / nloc;
        if (old + 1u == (gen + 1u) * nloc) {
            __builtin_amdgcn_fence(__ATOMIC_RELEASE, "agent");
            asm volatile("s_waitcnt vmcnt(0)" ::: "memory");
            const unsigned og = xb_add(&bar[XB_TOP], 1u);
            const unsigned tg = og / nx;
            if (og + 1u == (tg + 1u) * nx) xb_add(&bar[XB_TOPGEN], 1u);
            else XB_SPIN(xb_ld(&bar[XB_TOPGEN]) == tg, bar);
            __builtin_amdgcn_fence(__ATOMIC_ACQUIRE, "agent");
            xb_add(&bar[XB_XGEN(b.x)], 1u);
            asm volatile("s_waitcnt vmcnt(0)" ::: "memory");
        } else {
            XB_SPIN(xb_ld(&bar[XB_XGEN(b.x)]) == gen, bar);
            __builtin_amdgcn_fence(__ATOMIC_ACQUIRE, "agent");
            asm volatile("s_waitcnt vmcnt(0)" ::: "memory");
        }
    }
    __syncthreads();
}

__device__ __forceinline__ float rstd_of(const float* p) {
    const f32x4 a = *(const f32x4*)p, b = *(const f32x4*)(p + 4), c = *(const f32x4*)(p + 8), d = *(const f32x4*)(p + 12);
    const float s = (((a[0] + a[1]) + (a[2] + a[3])) + ((b[0] + b[1]) + (b[2] + b[3]))) + (((c[0] + c[1]) + (c[2] + c[3])) + ((d[0] + d[1]) + (d[2] + d[3])));
    return rsqrtf(s * (1.f / D) + EPS);
}
__device__ __forceinline__ void compute_rstd(LAS unsigned char* lds, const pg8::StaticOrder& S, const float* ssp) {
    const int tid = fresh_tid(), r = tid & 255, half = tid >> 8;
    LAS float* RS = (LAS float*)(lds + LDS_RS);
    f32x4 p[8][4]; bool ok[8];
#pragma unroll
    for (int k = 0; k < 8; ++k) {
        pg8::Unit u; ok[k] = S.next(2 * k + half, u);
        const float* q = ssp + (size_t)((ok[k] ? u.pm : 0) * 256 + r) * 16;
#pragma unroll
        for (int e = 0; e < 4; ++e) p[k][e] = ok[k] ? *(const f32x4*)(q + 4 * e) : (f32x4){0.f, 0.f, 0.f, 0.f};
    }
#pragma unroll
    for (int k = 0; k < 8; ++k) {
        const f32x4 a = p[k][0], b = p[k][1], c = p[k][2], d = p[k][3];
        const float s = (((a[0] + a[1]) + (a[2] + a[3])) + ((b[0] + b[1]) + (b[2] + b[3]))) + (((c[0] + c[1]) + (c[2] + c[3])) + ((d[0] + d[1]) + (d[2] + d[3])));
        if (ok[k]) RS[(2 * k + half) * 256 + r] = rsqrtf(s * (1.f / D) + EPS);
    }
    __syncthreads();
}
struct Args { const float* in[14]; float* out; unsigned char* ws; };

__global__ void __launch_bounds__(NTHR, 2) hybrid_fwd(Args args) {
    extern __shared__ __attribute__((aligned(16))) unsigned char lds_raw[];
    LAS unsigned char* lds = (LAS unsigned char*)lds_raw;
    cg::grid_group grid = cg::this_grid();
#define GRID_SYNC() xcd_barrier(xbar)
#define CG_SYNC() do { asm volatile("s_waitcnt vmcnt(0)" ::: "memory"); grid.sync(); } while (0)
    const int G = gridDim.x, bx = blockIdx.x, NGW = G * NWAVES;
#define FRESH_IDS const int tid = fresh_tid(), lane = tid & 63, wave = __builtin_amdgcn_readfirstlane(tid >> 6), gw = bx * NWAVES + wave; LAS float* scr = (LAS float*)(lds + wave * 16384); (void)tid; (void)lane; (void)gw; (void)scr
    unsigned char* ws = args.ws;
    const float* x_in = args.in[0]; const float* norm1 = args.in[1]; const float* w_in = args.in[2]; const float* lb_logits = args.in[3];
    const float* hg_norm = args.in[4]; const float* attn_sinks = args.in[5]; const float* w_pa = args.in[6]; const float* w_pb = args.in[7];
    const float* w_o = args.in[8]; const float* norm2 = args.in[9]; const float* w_gate = args.in[10]; const float* w_up = args.in[11];
    const float* w_down = args.in[12]; const float* final_norm = args.in[13];
    float* X = args.out;
    float* SSP = (float*)(ws + WS_SSP); float* LB = (float*)(ws + WS_LB); float* HD = (float*)(ws + WS_HD); float* ROPE = (float*)(ws + WS_ROPE);
    bf16_t* WIN = (bf16_t*)(ws + WS_WIN); bf16_t* WPA = (bf16_t*)(ws + WS_WPA); bf16_t* WPB = (bf16_t*)(ws + WS_WPB); bf16_t* WO = (bf16_t*)(ws + WS_WO);
    bf16_t* WGU = (bf16_t*)(ws + WS_WGU); bf16_t* WD = (bf16_t*)(ws + WS_WD);
    bf16_t* XB = (bf16_t*)(ws + WS_XB); bf16_t* QA = (bf16_t*)(ws + WS_QA); _Float16* LOGF = (_Float16*)(ws + WS_LOGF); bf16_t* VH = (bf16_t*)(ws + WS_V);
    bf16_t* GH = (bf16_t*)(ws + WS_GH); bf16_t* AK = (bf16_t*)(ws + WS_AK); bf16_t* AV = (bf16_t*)(ws + WS_AV); float* ST = (float*)(ws + WS_ST);
    unsigned* QCTR = (unsigned*)(ws + WS_BAR) + 3584;
    bf16_t* GATE = (bf16_t*)(ws + WS_GATE); bf16_t* GATEB = (bf16_t*)(ws + WS_LOGF); bf16_t* MIX = (bf16_t*)(ws + WS_MIX); bf16_t* ACT = (bf16_t*)(ws + WS_ACT);

    {
        FRESH_IDS;
        const int gt = bx * NTHR + tid, NGT = G * NTHR;
        { if (gt < 16) QCTR[gt] = 0u; for (int i = gt; i < XCD_BAR_WORDS; i += NGT) ((unsigned*)(ws + WS_BAR))[i] = 0u; if (tid < 64) ((LAS unsigned*)(lds + LDS_XB))[tid] = 0u; }
        for (int i = gt; i < 1024; i += NGT) {
            float l[4], mx = -INFINITY, s = 0.f;
#pragma unroll
            for (int k = 0; k < 4; ++k) { l[k] = lb_logits[k * 1024 + i]; mx = fmaxf(mx, l[k]); }
#pragma unroll
            for (int k = 0; k < 4; ++k) { l[k] = expf(l[k] - mx); s += l[k]; }
            float c = 0.f; const float p0 = l[0] / s;
#pragma unroll
            for (int k = 0; k < 4; ++k) { c += l[k] / s; LB[k * 1024 + i] = c - p0; }
        }
        for (int i = gt; i < SEQ * 8; i += NGT) {
            const int pos = i >> 3, k = i & 7;
            const float inv = (float)exp2(-(double)k * 0.125 * 18.931568569324174);
            const float ang = (float)pos * inv;
            const double a = (double)ang; const double kq = rint(a * 0.15915494309189535); const double r = a - kq * 6.283185307179586;
            ROPE[pos * 16 + k] = cosf((float)r); ROPE[pos * 16 + 8 + k] = sinf((float)r);
        }
        int ioff = 0;
        convert_matrix(w_in, D, NIN, norm1, WIN, 0, scr, gw, NGW, lane, ioff);
        convert_matrix(w_pa, D, D, nullptr, WPA, 0, scr, gw, NGW, lane, ioff, 2 * D);
        convert_matrix(w_pb, D, D, nullptr, WPA + D, 0, scr, gw, NGW, lane, ioff, 2 * D);
        convert_matrix(w_o, D, D, nullptr, WO, 0, scr, gw, NGW, lane, ioff);
        convert_matrix(w_gate, D, FF, norm2, WGU, 1, scr, gw, NGW, lane, ioff);
        convert_matrix(w_up, D, FF, norm2, WGU, 2, scr, gw, NGW, lane, ioff);
        convert_matrix(w_down, FF, D, nullptr, WD, 0, scr, gw, NGW, lane, ioff);
        for (int m0 = gw; m0 < T; m0 += 4 * NGW) {
            f32x4 v[4][4];
#pragma unroll
            for (int r = 0; r < 4; ++r)
#pragma unroll
                for (int j = 0; j < 4; ++j) v[r][j] = (m0 + r * NGW < T) ? ((const f32x4*)(x_in + (size_t)(m0 + r * NGW) * D) + lane)[64 * j] : (f32x4){0.f, 0.f, 0.f, 0.f};
#pragma unroll
            for (int r = 0; r < 4; ++r) {
                const int m = m0 + r * NGW; float s = 0.f;
                if (m >= T) break;
                unsigned long long* o8 = (unsigned long long*)(XB + (size_t)m * D) + lane;
#pragma unroll
                for (int j = 0; j < 4; ++j) { const f32x4 q = v[r][j]; s += (q.x * q.x + q.y * q.y) + (q.z * q.z + q.w * q.w); o8[64 * j] = (unsigned long long)pk2(q.x, q.y) | ((unsigned long long)pk2(q.z, q.w) << 32); }
                s = wave_sum(s);
                if (lane < 16) SSP[(size_t)m * 16 + lane] = (lane == 0) ? s : 0.f;
            }
        }
    }
    CG_SYNC();
    const XcdBarrier xbar = xcd_barrier_post((unsigned*)(ws + WS_BAR), (volatile LAS unsigned*)(lds + LDS_XB));

#pragma unroll 1
    for (int l = 0; l < DEPTH; ++l) {
        const float* ss1 = SSP + (size_t)(2 * l) * T * 16; float* ss2 = SSP + (size_t)(2 * l + 1) * T * 16; float* ss3 = SSP + (size_t)(2 * l + 2) * T * 16;
        const LAS float* RS = (const LAS float*)(lds + LDS_RS);
        {
            FRESH_IDS;
            if (l > 0) {
                int ioff = 0;
                convert_matrix(w_down + (size_t)l * FF * D, FF, D, nullptr, WD, 0, scr, gw, NGW, lane, ioff);
                convert_matrix(w_pa + (size_t)l * D * D, D, D, nullptr, WPA, 0, scr, gw, NGW, lane, ioff, 2 * D);
                convert_matrix(w_pb + (size_t)l * D * D, D, D, nullptr, WPA + D, 0, scr, gw, NGW, lane, ioff, 2 * D);
                convert_matrix(w_o + (size_t)l * D * D, D, D, nullptr, WO, 0, scr, gw, NGW, lane, ioff);
            }
            pg8::Gemm g{XB, WIN, T, NIN1, D, D}; pg8::StaticOrder S; S.init(T, NIN1, G, bx);
            compute_rstd(lds, S, ss1);
            EpiG1 E{RS, LB + l * 1024, ROPE, QA, LOGF, VH, GH, AK, AV};
            pg8::gemm_phase<EpiG1>(lds, g, S, E);
        }
        GRID_SYNC();
        {
            for (int u = bx; u < BATCH * HGH * NSC; u += G) if ((u % NSC) != NSC - 1) hgrn_unit<false>(lds, u, LOGF, QA, VH, GH, hg_norm + l * 1024, ST, HD);
        }
        GRID_SYNC();
        {
            for (int u = bx; u < BATCH * HGH * NSC; u += G) hgrn_unit<true>(lds, u, LOGF, QA, VH, GH, hg_norm + l * 1024, ST, HD);
            attn_phase(lds, QCTR + l, QA, AK, AV, attn_sinks + l * 16);
        }
        GRID_SYNC();
        {
            pg8::StaticOrder S; S.init(T, D, G, bx);
            compute_rstd(lds, S, ss1);
            {
            { pg8::StaticOrder S2 = S; S2.PAIR = true; pg8::Gemm g{XB, WIN + (size_t)NIN1 * D, T, 2 * D, D, D}; EpiGate E{RS, GATE, GATEB}; pg8::gemm_phase<EpiGate>(lds, g, S2, E); }
            { pg8::Gemm g{QA, WPA, T, D, 2 * D, 2 * D}; EpiMixK E{GATE, GATEB, MIX}; pg8::gemm_phase<EpiMixK>(lds, g, S, E); }
            }
        }
        GRID_SYNC();
        {
            pg8::Gemm g{MIX, WO, T, D, D, D}; pg8::StaticOrder S; S.init(T, D, G, bx);
            EpiRes E{XB, ss2};
            pg8::gemm_phase<EpiRes>(lds, g, S, E);
        }
        GRID_SYNC();
        {
            FRESH_IDS;
            if (l + 1 < DEPTH) {
                int ioff = 0;
                convert_matrix(w_in + (size_t)(l + 1) * D * NIN, D, NIN, norm1 + (l + 1) * D, WIN, 0, scr, gw, NGW, lane, ioff);
            }
            pg8::Gemm g{XB, WGU, T, NGU, D, D}; pg8::StaticOrder S; S.init(T, NGU, G, bx);
            compute_rstd(lds, S, ss2);
            EpiSwiglu E{RS, ACT};
            pg8::gemm_phase<EpiSwiglu>(lds, g, S, E);
        }
        GRID_SYNC();
        {
            FRESH_IDS;
            if (l + 1 < DEPTH) {
                int ioff = 0;
                convert_matrix(w_gate + (size_t)(l + 1) * D * FF, D, FF, norm2 + (l + 1) * D, WGU, 1, scr, gw, NGW, lane, ioff);
                convert_matrix(w_up + (size_t)(l + 1) * D * FF, D, FF, norm2 + (l + 1) * D, WGU, 2, scr, gw, NGW, lane, ioff);
            }
            __syncthreads();
            pg8::Gemm g{ACT, WD, T, D, FF, FF}; pg8::StaticOrder S; S.init(T, D, G, bx);
            EpiRes E{XB, ss3};
            pg8::gemm_phase<EpiRes>(lds, g, S, E);
        }
        GRID_SYNC();
    }
    {
        FRESH_IDS;
        const float* ssf = SSP + (size_t)8 * T * 16;
        f32x4 g4[4];
#pragma unroll
        for (int j = 0; j < 4; ++j) g4[j] = ((const f32x4*)final_norm + lane)[64 * j];
        for (int m0 = gw; m0 < T; m0 += 4 * NGW) {
            u32x2 v[4][4]; float rstd[4];
#pragma unroll
            for (int r = 0; r < 4; ++r) { const int m = m0 + r * NGW; const bool ok = m < T;
                rstd[r] = ok ? rstd_of(ssf + (size_t)m * 16) : 0.f;
#pragma unroll
                for (int j = 0; j < 4; ++j) v[r][j] = ok ? ((const u32x2*)(XB + (size_t)m * D) + lane)[64 * j] : (u32x2){0u, 0u}; }
#pragma unroll
            for (int r = 0; r < 4; ++r) { const int m = m0 + r * NGW; if (m >= T) break;
                f32x4* orow = (f32x4*)(X + (size_t)m * D) + lane;
#pragma unroll
                for (int j = 0; j < 4; ++j) orow[64 * j] = (f32x4){bf_lo(v[r][j].x), bf_hi(v[r][j].x), bf_lo(v[r][j].y), bf_hi(v[r][j].y)} * rstd[r] * g4[j]; }
        }
    }
}

extern "C" void kernel_launch(void* const* d_in, const int* in_sizes, int n_in, void* d_out, int out_size, void* d_ws, size_t ws_size, hipStream_t stream) {
    static int grid = 0;
    if (grid == 0) {
        if (n_in != 14 || out_size != T * D || ws_size < WS_END) { fprintf(stderr, "kernel_launch: unexpected shapes (n_in %d out %d ws %zu)\n", n_in, out_size, ws_size); grid = -1; return; }
        int dev = 0, cus = 0, per_cu = 0;
        hipGetDevice(&dev);
        hipDeviceGetAttribute(&cus, hipDeviceAttributeMultiprocessorCount, dev);
        if (hipFuncSetAttribute((const void*)hybrid_fwd, hipFuncAttributeMaxDynamicSharedMemorySize, LDS_BYTES) != hipSuccess) { fprintf(stderr, "kernel_launch: hipFuncSetAttribute failed\n"); grid = -1; return; }
        if (hipOccupancyMaxActiveBlocksPerMultiprocessor(&per_cu, (const void*)hybrid_fwd, NTHR, LDS_BYTES) != hipSuccess || per_cu < 1) { fprintf(stderr, "kernel_launch: occupancy query gave %d\n", per_cu); per_cu = 1; }
        (void)hipGetLastError();
        grid = cus * 1;
        if (grid > 256) grid = 256;
    }
    if (grid < 0) return;
    Args a{};
    for (int i = 0; i < 14; ++i) a.in[i] = (const float*)d_in[i];
    a.out = (float*)d_out; a.ws = (unsigned char*)d_ws;
    void* kargs[] = {&a};
    hipError_t e = hipLaunchCooperativeKernel((const void*)hybrid_fwd, dim3(grid), dim3(NTHR), kargs, LDS_BYTES, stream);
    if (e != hipSuccess) fprintf(stderr, "kernel_launch: cooperative launch failed: %s (grid %d)\n", hipGetErrorString(e), grid);
}
```

```cpp
#include <hip/hip_runtime.h>
#include <hip/hip_cooperative_groups.h>
#include <cstdio>
#include <cstdint>
namespace cg = cooperative_groups;

#define LAS __attribute__((address_space(3)))
typedef unsigned short bf16_t;
typedef short bf16x8 __attribute__((ext_vector_type(8)));
typedef short s16x4 __attribute__((ext_vector_type(4)));
typedef float f32x2 __attribute__((ext_vector_type(2)));
typedef float f32x4 __attribute__((ext_vector_type(4)));
typedef float f32x16 __attribute__((ext_vector_type(16)));
typedef unsigned u32x2 __attribute__((ext_vector_type(2)));
typedef unsigned u32x4 __attribute__((ext_vector_type(4)));
typedef __bf16 bf16x2_t __attribute__((ext_vector_type(2)));

constexpr int BATCH = 2, SEQ = 16384, T = BATCH * SEQ, D = 1024, DEPTH = 4;
constexpr int NIN = 7680, NIN1 = 5632, FF = 2816, NGU = 2 * FF;
constexpr int HGH = 8;
constexpr int SC_TOK = 1024, NSC = SEQ / SC_TOK, CH = 64, NCH = SC_TOK / CH;
constexpr float EPS = 1e-6f;
constexpr int NWAVES = 8, NTHR = 512;

constexpr size_t MiB = 1u << 20;
constexpr size_t WS_LB = 1280 * 1024;
constexpr size_t WS_HD = 1536 * 1024;
constexpr size_t WS_ROPE = 2 * MiB;
constexpr size_t WS_WIN = 3 * MiB, WS_WPA = 18 * MiB, WS_WPB = 20 * MiB, WS_WO = 22 * MiB, WS_WGU = 24 * MiB, WS_WD = 35 * MiB;
constexpr size_t WS_XB = 41 * MiB;
constexpr size_t WS_QA = 105 * MiB;
constexpr size_t WS_LOGF = 233 * MiB;
constexpr size_t WS_V = 297 * MiB;
constexpr size_t WS_GH = 361 * MiB;
constexpr size_t WS_AK = 425 * MiB, WS_AV = 441 * MiB;
constexpr size_t WS_ST = 457 * MiB;
constexpr size_t WS_SSP = 473 * MiB;
constexpr size_t WS_END = 492 * MiB;
constexpr int LDS_RS = 131072;
constexpr size_t WS_GATE = WS_V, WS_MIX = WS_GH, WS_ACT = WS_QA;
static_assert(WS_ACT + (size_t)T * FF * 2 <= WS_V, "ACT overlay");

constexpr int LDS_BYTES = 147456 + 256;
constexpr int LDS_XB = 147456;
constexpr size_t WS_BAR = 1792 * 1024;

__device__ __forceinline__ int fresh_tid() { int t = threadIdx.x; asm volatile("" : "+v"(t)); return t; }
namespace pg8 {
constexpr int BM = 256, BK = 64, HALF = 128, HTB = HALF * BK * 2, STAGE_BYTES = 8 * HTB, NXCD = 8, WGM = 4;
__host__ __device__ __forceinline__ int lds_byte(int r, int c) { const int st = (r >> 4) * 2 + (c >> 5), rr = r & 15, cc = c & 31, ob = rr * 64 + cc * 2; return st * 1024 + (ob ^ (((ob >> 9) & 1) << 5)); }
__host__ __device__ __forceinline__ void stage_rc(int b, int& R, int& C) { const int st = b / 1024, sb = b % 1024, swz = sb ^ (((sb >> 9) & 1) << 5); R = (st >> 1) * 16 + swz / 64; C = (st & 1) * 32 + (swz % 64) / 2; }
__host__ __device__ __forceinline__ int perm32(int rho) { const int n = rho >> 4, i = rho & 15; return 8 * (i >> 2) + 4 * n + (i & 3); }
__device__ __forceinline__ void glds16s(const void* sbase, unsigned voff, unsigned lds_dst) {
    unsigned keep;
    asm volatile("s_mov_b32 %0, m0\n\ts_mov_b32 m0, %3\n\ts_nop 0\n\tglobal_load_lds_dwordx4 %1, %2\n\ts_mov_b32 m0, %0" : "=&s"(keep) : "v"(voff), "s"(sbase), "s"(lds_dst) : "memory");
}
struct Unit { int pm, pn, idx; };
struct Gemm { const bf16_t* A; const bf16_t* Bt; int M, N, K, lda; };
struct StaticOrder {
    int nM, nN, nwg, G, c; bool PAIR = false;
    __host__ __device__ void init(int M, int N, int G_, int c_) { nM = M / BM; nN = N / BM; nwg = nM * nN; G = G_; c = c_; }
    __host__ __device__ bool next(int i, Unit& u) const {
        if (PAIR) { if (!next1(i >> 1, u)) return false; u.pn += (i & 1) * nN; return true; }
        return next1(i, u);
    }
    __host__ __device__ bool next1(int i, Unit& u) const {
        const long L = (long)i * G + c; if (L >= nwg) return false;
        int wgid = (int)L; { const int q = nwg / NXCD, r = nwg % NXCD, xcd = wgid % NXCD, off = wgid / NXCD; wgid = (xcd < r ? xcd * (q + 1) : r * (q + 1) + (xcd - r) * q) + off; }
        const int nig = WGM * nN, gid = wgid / nig, fm = gid * WGM, gsz = (nM - fm) < WGM ? (nM - fm) : WGM;
        u.pm = fm + ((wgid % nig) % gsz); u.pn = (wgid % nig) / gsz; u.idx = i; return true;
    }
};
template <class Epi, bool ALIGN_EPI = true>
__device__ __forceinline__ void gemm_phase(LAS unsigned char* lds, const Gemm g, const StaticOrder& S, const Epi& E) {
    const int tid = fresh_tid(), wid = __builtin_amdgcn_readfirstlane(tid >> 6), lane = tid & 63, wr = wid >> 2, wc = wid & 3, fr = lane & 15, fq = lane >> 4;
    const int K = g.K, nt = K / BK, lda = g.lda;
    unsigned voffA[2], voffB[2];
#pragma unroll
    for (int i = 0; i < 2; ++i) { int R, C; stage_rc(tid * 16 + i * 8192, R, C); const int Rb = (R & ~31) + perm32(R & 31);
        voffA[i] = (unsigned)(R * lda + C) * 2u; voffB[i] = (unsigned)(Rb * K + C) * 2u; }
    const size_t kstep = (size_t)(BK * 2);
    const size_t hstepA = (size_t)HALF * lda * 2, hstepB = (size_t)HALF * K * 2;
    const size_t tstepA = 2 * hstepA, tstepB = 2 * hstepB;
    const unsigned ldsw = (unsigned)wid * 1024u, ldsb = (unsigned)(size_t)lds;
    const int aoff = lds_byte(wr * 64 + fr, fq * 8), boff = lds_byte(wc * 32 + fr, fq * 8);
#define PG8_SA(b, h) (((b) * 2 + (h)) * HTB)
#define PG8_SB(b, h) ((4 + (b) * 2 + (h)) * HTB)
#define PG8_STAGE(bufoff, gbase, voff) do { _Pragma("unroll") for (int _i = 0; _i < 2; ++_i) \
        glds16s((const void*)(gbase), (voff)[_i], ldsb + (unsigned)(bufoff) + ldsw + (unsigned)(_i * 8192)); } while (0)
#define PG8_LDA(dst, b, h) do { _Pragma("unroll") for (int m = 0; m < 4; ++m) _Pragma("unroll") for (int k = 0; k < 2; ++k) dst[m][k] = *(const LAS bf16x8*)(lds + PG8_SA(b, h) + aoff + m * 2048 + k * 1024); } while (0)
#define PG8_LDB(dst, b, h) do { _Pragma("unroll") for (int n = 0; n < 2; ++n) _Pragma("unroll") for (int k = 0; k < 2; ++k) dst[n][k] = *(const LAS bf16x8*)(lds + PG8_SB(b, h) + boff + n * 2048 + k * 1024); } while (0)
#define PG8_MMA(ai, bj, At, Bt) do { __builtin_amdgcn_s_setprio(1); _Pragma("unroll") for (int m = 0; m < 4; ++m) _Pragma("unroll") for (int n = 0; n < 2; ++n) _Pragma("unroll") for (int k = 0; k < 2; ++k) \
        acc[ai][bj][m][n] = __builtin_amdgcn_mfma_f32_16x16x32_bf16(Bt[n][k], At[m][k], acc[ai][bj][m][n], 0, 0, 0); __builtin_amdgcn_s_setprio(0); } while (0)
#define PG8_WAIT_V(n) asm volatile("s_waitcnt vmcnt(" #n ")" ::: "memory")
#define PG8_WAIT_L(n) asm volatile("s_waitcnt lgkmcnt(" #n ")" ::: "memory")
#define PG8_BAR __builtin_amdgcn_s_barrier()
#define PG8_SCHED __builtin_amdgcn_sched_barrier(0)
    Unit cur, nxt; int ui = 0;
    if (!S.next(0, cur)) return;
    f32x4 acc[2][2][4][2];
#pragma unroll
    for (int a = 0; a < 2; ++a)
#pragma unroll
        for (int b = 0; b < 2; ++b)
#pragma unroll
            for (int m = 0; m < 4; ++m)
#pragma unroll
                for (int n = 0; n < 2; ++n) acc[a][b][m][n] = (f32x4){0.f, 0.f, 0.f, 0.f};
    bf16x8 At[4][2], B0[2][2], B1[2][2];
    const char* cA = (const char*)g.A + (size_t)cur.pm * tstepA; const char* cB = (const char*)g.Bt + (size_t)cur.pn * tstepB;
    PG8_STAGE(PG8_SB(0, 0), cB, voffB); PG8_STAGE(PG8_SB(0, 1), cB + hstepB, voffB); PG8_STAGE(PG8_SA(0, 0), cA, voffA); PG8_STAGE(PG8_SA(0, 1), cA + hstepA, voffA);
    if (wr == 1) PG8_BAR;
    PG8_WAIT_V(2); PG8_BAR;
    PG8_STAGE(PG8_SB(1, 0), cB + kstep, voffB); PG8_STAGE(PG8_SA(1, 0), cA + kstep, voffA); PG8_STAGE(PG8_SB(1, 1), cB + hstepB + kstep, voffB);
    PG8_WAIT_V(6); PG8_BAR;
    for (;;) {
        const bool has_next = S.next(ui + 1, nxt);
        const char* nA = has_next ? (const char*)g.A + (size_t)nxt.pm * tstepA : cA; const char* nB = has_next ? (const char*)g.Bt + (size_t)nxt.pn * tstepB : cB;
        for (int t = 0; t < nt; t += 2) {
            if constexpr (Epi::HOOK) { if (t == nt / 2) E.hook(acc, cur, wr, wc, fr, fq); }
            const bool last = (t == nt - 2);
            const char* a1 = cA + (size_t)(t + 1) * kstep;
            const char* a2 = last ? nA : cA + (size_t)(t + 2) * kstep; const char* b2 = last ? nB : cB + (size_t)(t + 2) * kstep;
            const char* a3 = a2 + kstep; const char* b3 = b2 + kstep;
            PG8_LDB(B0, 0, 0); PG8_LDB(B1, 0, 1); PG8_SCHED; PG8_LDA(At, 0, 0); PG8_STAGE(PG8_SA(1, 1), a1 + hstepA, voffA);
            PG8_WAIT_V(8); PG8_WAIT_L(0); PG8_BAR; PG8_MMA(0, 0, At, B0); PG8_MMA(0, 1, At, B1); PG8_BAR; PG8_SCHED;
            PG8_LDA(At, 0, 1); PG8_STAGE(PG8_SB(0, 0), b2, voffB); PG8_STAGE(PG8_SB(0, 1), b2 + hstepB, voffB); PG8_STAGE(PG8_SA(0, 0), a2, voffA);
            PG8_WAIT_V(8); PG8_WAIT_L(0); PG8_BAR; PG8_MMA(1, 0, At, B0); PG8_MMA(1, 1, At, B1); PG8_BAR; PG8_SCHED;
            PG8_LDB(B0, 1, 0); PG8_LDB(B1, 1, 1); PG8_SCHED; PG8_LDA(At, 1, 0); PG8_STAGE(PG8_SA(0, 1), a2 + hstepA, voffA);
            PG8_WAIT_V(8); PG8_WAIT_L(0); PG8_BAR; PG8_MMA(0, 0, At, B0); PG8_MMA(0, 1, At, B1); PG8_BAR; PG8_SCHED;
            PG8_LDA(At, 1, 1); PG8_STAGE(PG8_SB(1, 0), b3, voffB); PG8_STAGE(PG8_SB(1, 1), b3 + hstepB, voffB); PG8_STAGE(PG8_SA(1, 0), a3, voffA);
            PG8_WAIT_V(8); PG8_WAIT_L(0); PG8_BAR; PG8_MMA(1, 0, At, B0); PG8_MMA(1, 1, At, B1); PG8_BAR; PG8_SCHED;
        }
        if constexpr (ALIGN_EPI) { if (wr == 0) PG8_BAR; }
        E(acc, cur, wr, wc, fr, fq);
        if (!has_next) break;
#pragma unroll
        for (int a = 0; a < 2; ++a)
#pragma unroll
            for (int b = 0; b < 2; ++b)
#pragma unroll
                for (int m = 0; m < 4; ++m)
#pragma unroll
                    for (int n = 0; n < 2; ++n) acc[a][b][m][n] = (f32x4){0.f, 0.f, 0.f, 0.f};
        cur = nxt; cA = nA; cB = nB; ++ui;
        if constexpr (ALIGN_EPI) { if (wr == 1) PG8_BAR; }
    }
    PG8_WAIT_V(0);
    if constexpr (!ALIGN_EPI) { if (wr == 0) PG8_BAR; }
    PG8_BAR;
#undef PG8_SA
#undef PG8_SB
#undef PG8_STAGE
#undef PG8_LDA
#undef PG8_LDB
#undef PG8_MMA
#undef PG8_WAIT_V
#undef PG8_WAIT_L
#undef PG8_BAR
#undef PG8_SCHED
}
}

__device__ __forceinline__ unsigned pk2(float lo, float hi) { f32x2 v = {lo, hi}; bf16x2_t b = __builtin_convertvector(v, bf16x2_t); return __builtin_bit_cast(unsigned, b); }
__device__ __forceinline__ float bf_lo(unsigned u) { return __uint_as_float(u << 16); }
__device__ __forceinline__ float bf_hi(unsigned u) { return __uint_as_float(u & 0xffff0000u); }
__device__ __forceinline__ float rcpf(float x) { return __builtin_amdgcn_rcpf(x); }
__device__ __forceinline__ float sigmoidf_(float x) { return rcpf(1.f + __expf(-x)); }
__device__ __forceinline__ float siluf_(float x) { return x * sigmoidf_(x); }
template <int MASK> __device__ __forceinline__ float shx(float v) {
    if constexpr (MASK < 32) return __builtin_bit_cast(float, __builtin_amdgcn_ds_swizzle(__builtin_bit_cast(int, v), (MASK << 10) | 0x1f));
    else { int self = (int)__builtin_amdgcn_mbcnt_hi(~0u, __builtin_amdgcn_mbcnt_lo(~0u, 0u)); asm volatile("" : "+v"(self)); return __builtin_bit_cast(float, __builtin_amdgcn_ds_bpermute((self ^ MASK) << 2, __builtin_bit_cast(int, v))); }
}
__device__ __forceinline__ float wave_sum(float v) {
    v += shx<1>(v); v += shx<2>(v); v += shx<4>(v); v += shx<8>(v); v += shx<16>(v); v += shx<32>(v);
    return v;
}
#define LDS_WAIT() asm volatile("s_waitcnt lgkmcnt(0)" ::: "memory")
#define MFMA32(a, b, c) __builtin_amdgcn_mfma_f32_32x32x16_bf16((a), (b), (c), 0, 0, 0)
__device__ __forceinline__ int crow(int e, int hh) { return (e & 3) + 8 * (e >> 2) + 4 * hh; }

using pg8::Unit;
typedef const f32x4 (&AccRef)[2][2][4][2];

#define NT_STORE16(ptr, val) (*(u32x4*)(void*)(ptr) = (val))
__device__ __forceinline__ float fast_sigmoid(float x) { return rcpf(1.f + __builtin_amdgcn_exp2f(x * -1.4426950408889634f)); }
struct EpiG1 {
    static constexpr bool HOOK = false;
    const LAS float* rs; const float* lb; const float* rope; bf16_t* QA; _Float16* LOGF; bf16_t* V; bf16_t* GH; bf16_t* AK; bf16_t* AV;
    template <int KIND> __device__ __forceinline__ void run(AccRef acc, const Unit& u, int wr, int wc, int fr, int fq, bf16_t* dst, int ldd, int cl, float scale) const {
        const int row0 = u.pm * 256 + wr * 64 + fr;
        f32x4 l0[2], l1[2];
        if (KIND == 1) {
#pragma unroll
            for (int bj = 0; bj < 2; ++bj) { l0[bj] = *(const f32x4*)(lb + cl + bj * 128); l1[bj] = *(const f32x4*)(lb + cl + bj * 128 + 4); }
        }
        f32x4 rn[4];
        if (KIND == 3) { const int pos = row0 & (SEQ - 1);
#pragma unroll
            for (int k = 0; k < 4; ++k) rn[k] = *(const f32x4*)(rope + pos * 16 + 4 * k); }
#pragma unroll
        for (int ai = 0; ai < 2; ++ai)
#pragma unroll
            for (int m = 0; m < 4; ++m) {
                const int row = row0 + ai * 128 + m * 16;
                const float rstd = rs[u.idx * 256 + wr * 64 + fr + ai * 128 + m * 16];
                f32x4 c0, c1, s0, s1;
                if (KIND == 3) {
                    c0 = rn[0]; c1 = rn[1]; s0 = rn[2]; s1 = rn[3];
                    if (ai * 4 + m + 1 < 8) { const int gi = ai * 4 + m + 1, pos = (row0 + (gi >> 2) * 128 + (gi & 3) * 16) & (SEQ - 1);
#pragma unroll
                        for (int k = 0; k < 4; ++k) rn[k] = *(const f32x4*)(rope + pos * 16 + 4 * k); }
                }
#pragma unroll
                for (int bj = 0; bj < 2; ++bj) {
                    float v[8];
#pragma unroll
                    for (int e = 0; e < 4; ++e) { v[e] = acc[ai][bj][m][0][e] * rstd; v[4 + e] = acc[ai][bj][m][1][e] * rstd; }
                    const int c = cl + bj * 128;
                    u32x4 w;
                    if (KIND == 0) {
#pragma unroll
                        for (int e = 0; e < 8; ++e) v[e] = v[e] * fast_sigmoid(v[e]);
                    } else if (KIND == 1) {
                        _Float16 h[8];
#pragma unroll
                        for (int e = 0; e < 8; ++e) { const float lbv = e < 4 ? l0[bj][e] : l1[bj][e - 4]; const float f = lbv + (1.f - lbv) * fast_sigmoid(v[e]);
                            h[e] = (_Float16)(__builtin_amdgcn_logf(fmaxf(f, 1e-30f)) * 0.6931471805599453f); }
#pragma unroll
                        for (int e = 0; e < 4; ++e) w[e] = (unsigned)__builtin_bit_cast(unsigned short, h[2 * e]) | ((unsigned)__builtin_bit_cast(unsigned short, h[2 * e + 1]) << 16);
                    } else if (KIND == 3) {
                        if ((wc & 1) == 0) {
#pragma unroll
                            for (int e = 0; e < 8; ++e) {
                                const float cs = e < 4 ? c0[e] : c1[e - 4], sn = e < 4 ? s0[e] : s1[e - 4];
                                const float p = shx<16>(v[e]);
                                const float r = (fq == 0) ? (v[e] * cs - p * sn) : (v[e] * cs + p * sn);
                                v[e] = (fq < 2) ? r : v[e];
                            }
                        }
#pragma unroll
                        for (int e = 0; e < 8; ++e) v[e] *= scale;
                    }
                    if (KIND != 1) { w = (u32x4){pk2(v[0], v[1]), pk2(v[2], v[3]), pk2(v[4], v[5]), pk2(v[6], v[7])}; }
                    NT_STORE16(dst + (size_t)row * ldd + c, w);
                }
            }
    }
    __device__ __forceinline__ void operator()(AccRef acc, const Unit& u, int wr, int wc, int fr, int fq) const {
        const int pn = u.pn;
        const int cl = (pn < 20 ? (pn & 3) * 256 : 0) + wc * 32 + 8 * fq;
        if (pn < 4) run<0>(acc, u, wr, wc, fr, fq, QA, 2048, cl, 1.f);
        else if (pn < 8) run<1>(acc, u, wr, wc, fr, fq, (bf16_t*)LOGF, 1024, cl, 1.f);
        else if (pn < 12) run<2>(acc, u, wr, wc, fr, fq, V, 1024, cl, 1.f);
        else if (pn < 16) run<0>(acc, u, wr, wc, fr, fq, GH, 1024, cl, 1.f);
        else if (pn < 20) run<3>(acc, u, wr, wc, fr, fq, QA + 1024, 2048, cl, 0.125f);
        else if (pn == 20) run<3>(acc, u, wr, wc, fr, fq, AK, 256, cl, 1.f);
        else run<2>(acc, u, wr, wc, fr, fq, AV, 256, cl, 1.f);
    }
};

struct EpiGate {
    static constexpr bool HOOK = false;
    const LAS float* rs; bf16_t* G; bf16_t* G2;
    __device__ __forceinline__ void operator()(AccRef acc, const Unit& u, int wr, int wc, int fr, int fq) const {
        const int row0 = u.pm * 256 + wr * 64 + fr, c0 = (u.pn & 3) * 256 + wc * 32 + 8 * fq; bf16_t* G = u.pn < 4 ? this->G : G2;
#pragma unroll
        for (int ai = 0; ai < 2; ++ai)
#pragma unroll
            for (int m = 0; m < 4; ++m) {
                const int row = row0 + ai * 128 + m * 16;
                const float rstd = rs[u.idx * 256 + wr * 64 + fr + ai * 128 + m * 16];
#pragma unroll
                for (int bj = 0; bj < 2; ++bj) {
                    float v[8];
#pragma unroll
                    for (int e = 0; e < 4; ++e) { v[e] = sigmoidf_(acc[ai][bj][m][0][e] * rstd); v[4 + e] = sigmoidf_(acc[ai][bj][m][1][e] * rstd); }
                    u32x4 w = {pk2(v[0], v[1]), pk2(v[2], v[3]), pk2(v[4], v[5]), pk2(v[6], v[7])};
                    NT_STORE16(G + (size_t)row * 1024 + c0 + bj * 128, w);
                }
            }
    }
};
struct EpiMixK {
    static constexpr bool HOOK = true;
    const bf16_t* GA; const bf16_t* GB; bf16_t* MIX;
    static __device__ __forceinline__ unsigned goff(int gi) { return (unsigned)(((((gi >> 3) & 1) * 128 + ((gi >> 1) & 3) * 16) * 1024 + (gi & 1) * 128) * 2); }
    __device__ __forceinline__ void hook(f32x4 (&acc)[2][2][4][2], const Unit& u, int wr, int wc, int fr, int fq) const {
        int row0 = u.pm * 256 + wr * 64 + fr; const int c0 = u.pn * 256 + wc * 32 + 8 * fq;
        asm volatile("" : "+v"(row0));
        const unsigned vb = ((unsigned)row0 * 1024u + (unsigned)c0) * 2u;
#pragma unroll
        for (int h8 = 0; h8 < 2; ++h8) {
            u32x4 ga[8], gb[8];
#pragma unroll
            for (int k = 0; k < 8; ++k) { ga[k] = *(const u32x4*)((const char*)GA + vb + goff(8 * h8 + k)); gb[k] = *(const u32x4*)((const char*)GB + vb + goff(8 * h8 + k)); }
            asm volatile("" ::: "memory");
#pragma unroll
            for (int k = 0; k < 8; ++k) {
                const int gi = 8 * h8 + k, ai = (gi >> 3) & 1, m = (gi >> 1) & 3, bj = gi & 1;
#pragma unroll
                for (int e = 0; e < 4; ++e) {
                    const float r0 = bf_lo(ga[k][e]) * rcpf(fmaxf(bf_lo(gb[k][e]), 1e-30f)), r1 = bf_hi(ga[k][e]) * rcpf(fmaxf(bf_hi(gb[k][e]), 1e-30f));
                    if (e < 2) { acc[ai][bj][m][0][2 * e] *= r0; acc[ai][bj][m][0][2 * e + 1] *= r1; } else { acc[ai][bj][m][1][2 * e - 4] *= r0; acc[ai][bj][m][1][2 * e - 3] *= r1; }
                }
            }
            asm volatile("" ::: "memory");
        }
    }
    __device__ __forceinline__ void operator()(AccRef acc, const Unit& u, int wr, int wc, int fr, int fq) const {
        const int row0 = u.pm * 256 + wr * 64 + fr, c0 = u.pn * 256 + wc * 32 + 8 * fq;
        const unsigned vb = ((unsigned)row0 * 1024u + (unsigned)c0) * 2u;
#pragma unroll
        for (int q4 = 0; q4 < 2; ++q4) {
            u32x4 gb[8];
#pragma unroll
            for (int k = 0; k < 8; ++k) gb[k] = *(const u32x4*)((const char*)GB + vb + goff(8 * q4 + k));
            asm volatile("" ::: "memory");
#pragma unroll
            for (int k = 0; k < 8; ++k) {
                const int gi = 8 * q4 + k, ai = (gi >> 3) & 1, m = (gi >> 1) & 3, bj = gi & 1;
                u32x4 w;
#pragma unroll
                for (int e = 0; e < 4; ++e) {
                    const float a0 = e < 2 ? acc[ai][bj][m][0][2 * e] : acc[ai][bj][m][1][2 * e - 4], a1 = e < 2 ? acc[ai][bj][m][0][2 * e + 1] : acc[ai][bj][m][1][2 * e - 3];
                    w[e] = pk2(a0 * bf_lo(gb[k][e]), a1 * bf_hi(gb[k][e]));
                }
                NT_STORE16((const char*)MIX + vb + goff(gi), w);
            }
        }
    }
};
struct EpiRes {   static constexpr bool HOOK = false;
    bf16_t* XB; float* sspout;
    __device__ __forceinline__ void operator()(AccRef acc, const Unit& u, int wr, int wc, int fr, int fq) const {
        const int row0 = u.pm * 256 + wr * 64 + fr, c0 = u.pn * 256 + wc * 32 + 8 * fq;
        u32x4 bs[2][4][2];
#pragma unroll
        for (int ai = 0; ai < 2; ++ai)
#pragma unroll
            for (int m = 0; m < 4; ++m)
#pragma unroll
                for (int bj = 0; bj < 2; ++bj) bs[ai][m][bj] = *(const u32x4*)(XB + (size_t)(row0 + ai * 128 + m * 16) * 1024 + c0 + bj * 128);
        asm volatile("" ::: "memory");
#pragma unroll
        for (int ai = 0; ai < 2; ++ai)
#pragma unroll
            for (int m = 0; m < 4; ++m) {
                const int row = row0 + ai * 128 + m * 16; float sq = 0.f;
#pragma unroll
                for (int bj = 0; bj < 2; ++bj) {
                    const size_t off = (size_t)row * 1024 + c0 + bj * 128;
                    const u32x4 b = bs[ai][m][bj];
                    u32x4 w;
#pragma unroll
                    for (int e = 0; e < 4; ++e) {
                        const float a0 = e < 2 ? acc[ai][bj][m][0][2 * e] : acc[ai][bj][m][1][2 * e - 4], a1 = e < 2 ? acc[ai][bj][m][0][2 * e + 1] : acc[ai][bj][m][1][2 * e - 3];
                        w[e] = pk2(bf_lo(b[e]) + a0, bf_hi(b[e]) + a1);
                        const float r0 = bf_lo(w[e]), r1 = bf_hi(w[e]); sq += r0 * r0 + r1 * r1;
                    }
                    *(u32x4*)(XB + off) = w;
                }
                sq += shx<16>(sq); sq += shx<32>(sq);
                if (fq == 0) sspout[(size_t)row * 16 + u.pn * 4 + wc] = sq;
            }
    }
};
struct EpiSwiglu {
    static constexpr bool HOOK = false;
    const LAS float* rs; bf16_t* ACT;
    __device__ __forceinline__ void operator()(AccRef acc, const Unit& u, int wr, int wc, int fr, int fq) const {
        const int row0 = u.pm * 256 + wr * 64 + fr, c0 = u.pn * 128 + wc * 32 + 8 * fq;
#pragma unroll
        for (int ai = 0; ai < 2; ++ai)
#pragma unroll
            for (int m = 0; m < 4; ++m) {
                const int row = row0 + ai * 128 + m * 16;
                const float rstd = rs[u.idx * 256 + wr * 64 + fr + ai * 128 + m * 16];
                float v[8];
#pragma unroll
                for (int e = 0; e < 4; ++e) { v[e] = siluf_(acc[ai][0][m][0][e] * rstd) * (acc[ai][1][m][0][e] * rstd); v[4 + e] = siluf_(acc[ai][0][m][1][e] * rstd) * (acc[ai][1][m][1][e] * rstd); }
                u32x4 w = {pk2(v[0], v[1]), pk2(v[2], v[3]), pk2(v[4], v[5]), pk2(v[6], v[7])};
                NT_STORE16(ACT + (size_t)row * FF + c0, w);
            }
    }
};

#define CV_LOAD(dst, k0_, n0_) do { _Pragma("unroll") for (int i = 0; i < 32; ++i) dst[i] = W[(size_t)((k0_) + 2 * i + (lane >> 5)) * N + (n0_) + (lane & 31)]; } while (0)
__device__ __forceinline__ void convert_matrix(const float* W, int K, int N, const float* gain, bf16_t* WT, int mode, LAS float* scr, int gw, int NGW, int lane, int& ioff, int ldt = 0) {
    if (ldt == 0) ldt = K;
    const int nblk = N / 32, nitems = (K / 64) * nblk;
    int it0 = (gw - ioff) % NGW; if (it0 < 0) it0 += NGW;
    ioff = (ioff + nitems) % NGW;
    float wn[32];
    if (it0 < nitems) CV_LOAD(wn, (it0 / nblk) * 64, (it0 % nblk) * 32);
    const int c = lane & 7;
    for (int it = it0; it < nitems; it += NGW) {
        const int kb = it / nblk, nb = it % nblk, n0 = nb * 32, k0 = kb * 64;
        const int dst = mode == 0 ? n0 : 256 * (n0 / 128) + (n0 % 128) + (mode == 2 ? 128 : 0);
        f32x4 g0 = {1.f, 1.f, 1.f, 1.f}, g1 = {1.f, 1.f, 1.f, 1.f};
        if (gain) { g0 = *(const f32x4*)(gain + k0 + 8 * c); g1 = *(const f32x4*)(gain + k0 + 8 * c + 4); }
#pragma unroll
        for (int i = 0; i < 32; ++i) scr[(2 * i + (lane >> 5)) * 33 + (lane & 31)] = wn[i];
        const int itn = it + NGW;
        if (itn < nitems) CV_LOAD(wn, (itn / nblk) * 64, (itn % nblk) * 32);
        LDS_WAIT(); asm volatile("" ::: "memory");
#pragma unroll
        for (int j = 0; j < 4; ++j) { const int n = (lane >> 3) + 8 * j; const LAS float* s = scr + (8 * c) * 33 + n;
            u32x4 o = {pk2(s[0 * 33] * g0[0], s[1 * 33] * g0[1]), pk2(s[2 * 33] * g0[2], s[3 * 33] * g0[3]), pk2(s[4 * 33] * g1[0], s[5 * 33] * g1[1]), pk2(s[6 * 33] * g1[2], s[7 * 33] * g1[3])};
            *(u32x4*)(WT + (size_t)(dst + n) * ldt + k0 + 8 * c) = o; }
        LDS_WAIT(); asm volatile("" ::: "memory");
    }
}
#undef CV_LOAD

constexpr int H_QT = 0, H_KC = 17408, H_KCT = 34816, H_VT = 53248, H_SBT = 71680, H_OST = 106496, H_ER = 140288, H_PFX = 140800;
constexpr int H_HGW = H_PFX + 4096;
static_assert(H_HGW + 512 <= LDS_XB, "hgrn lds");
template <bool OUT>
__device__ __forceinline__ void hgrn_unit(LAS unsigned char* lds, int unit, const _Float16* LOGF, bf16_t* QA, const bf16_t* V, const bf16_t* GH, const float* hgw  ,
                                          float* ST, float* HD) {
    const int tid = fresh_tid(), w = __builtin_amdgcn_readfirstlane(tid >> 6), lane = tid & 63, n = lane & 31, hh = lane >> 5;
    const int bh = unit / NSC, sc = unit % NSC, b = bh / HGH, h = bh % HGH;
    const int cb = w & 3, dvb0 = 2 * (w >> 2);
    const int tbO = w >> 2, dvbO = w & 3;
    LAS float* ER = (LAS float*)(lds + H_ER); LAS float* PFX = (LAS float*)(lds + H_PFX);
    f32x16 S[2];
#pragma unroll
    for (int e = 0; e < 16; ++e) { S[0][e] = 0.f; S[1][e] = 0.f; }
    if (OUT && sc > 0) {
        f32x4 wg[4];
#pragma unroll
        for (int jj = 0; jj < 4; ++jj) wg[jj] = (f32x4){1.f, 1.f, 1.f, 1.f};
        f32x16 L0[2], L1[2], L2[2]; f32x4 d0[4], d1[4], d2[4];
#define HG_LDSTATE(L_, d_, jj_) do { const bool ok_ = (jj_) >= 0; const int uj_ = bh * NSC + (ok_ ? (jj_) : 0); const unsigned* Lp_ = (const unsigned*)ST + (size_t)uj_ * 8192 + (size_t)(w * 16) * 64 + lane; \
            _Pragma("unroll") for (int tl = 0; tl < 2; ++tl) _Pragma("unroll") for (int e = 0; e < 8; ++e) { const unsigned pw_ = ok_ ? Lp_[(tl * 8 + e) * 64] : 0u; L_[tl][2 * e] = bf_lo(pw_); L_[tl][2 * e + 1] = bf_hi(pw_); } \
            _Pragma("unroll") for (int q = 0; q < 4; ++q) d_[q] = ok_ ? *(const f32x4*)(HD + (size_t)uj_ * 128 + 32 * cb + 8 * q + 4 * hh) : (f32x4){1.f, 1.f, 1.f, 1.f}; } while (0)
#define HG_ACC(L_, d_) do { _Pragma("unroll") for (int tl = 0; tl < 2; ++tl) _Pragma("unroll") for (int e = 0; e < 16; ++e) S[tl][e] += wg[e >> 2][e & 3] * L_[tl][e]; \
            _Pragma("unroll") for (int q = 0; q < 4; ++q) wg[q] *= d_[q]; } while (0)
        for (int j = sc - 1; j >= 0; j -= 3) {
            HG_LDSTATE(L0, d0, j); HG_LDSTATE(L1, d1, j - 1); HG_LDSTATE(L2, d2, j - 2);
            HG_ACC(L0, d0); HG_ACC(L1, d1); HG_ACC(L2, d2);
        }
#undef HG_ACC
#undef HG_LDSTATE
    }
    float dlog0 = 0.f, dlog1 = 0.f;
    const int c0 = 2 * lane;
    if (OUT && tid < 128) *(LAS float*)(lds + H_HGW + tid * 4) = hgw[h * 128 + tid];
    const size_t tok_sc = (size_t)b * SEQ + (size_t)sc * SC_TOK;
    unsigned gq[8], qq[8], vq[8];
#define HG_LOAD(chn) do { const size_t t0_ = tok_sc + (size_t)(chn) * CH; _Pragma("unroll") for (int i = 0; i < 8; ++i) { const size_t row_ = t0_ + 8 * w + i; \
        gq[i] = *(const unsigned*)(LOGF + row_ * 1024 + h * 128 + c0); vq[i] = *(const unsigned*)(V + row_ * 1024 + h * 128 + c0); \
        if (OUT) qq[i] = *(const unsigned*)(QA + row_ * 2048 + h * 128 + c0); } } while (0)
#pragma unroll 1
    for (int ch = 0; ch < NCH; ++ch) {
        const size_t tok0 = tok_sc + (size_t)ch * CH;
        if (ch == 0) HG_LOAD(0);
        float b0[8], b1[8]; float a0 = 0.f, a1 = 0.f;
#pragma unroll
        for (int i = 0; i < 8; ++i) {
            const float g0 = (float)__builtin_bit_cast(_Float16, (unsigned short)(gq[i] & 0xffffu)), g1 = (float)__builtin_bit_cast(_Float16, (unsigned short)(gq[i] >> 16));
            a0 += g0; a1 += g1; b0[i] = a0; b1[i] = a1;
        }
        *(LAS f32x2*)(PFX + w * 128 + c0) = (f32x2){a0, a1};
        LDS_WAIT(); __builtin_amdgcn_s_barrier(); asm volatile("" ::: "memory");
        float p0 = 0.f, p1 = 0.f, t0 = 0.f, t1 = 0.f;
#pragma unroll
        for (int ww = 0; ww < 8; ++ww) { const f32x2 x = *(const LAS f32x2*)(PFX + ww * 128 + c0); t0 += x.x; t1 += x.y; if (ww < w) { p0 += x.x; p1 += x.y; } }
        const float r0 = 0.5f * t0, r1 = 0.5f * t1;
        if (w == 0) *(LAS f32x2*)(ER + c0) = (f32x2){__expf(r0), __expf(r1)};
        dlog0 += t0; dlog1 += t1;
        float kc0[8], kc1[8];
#pragma unroll
        for (int i = 0; i < 8; ++i) {
            const float g0 = (float)__builtin_bit_cast(_Float16, (unsigned short)(gq[i] & 0xffffu)), g1 = (float)__builtin_bit_cast(_Float16, (unsigned short)(gq[i] >> 16));
            const float bt0 = p0 + b0[i], bt1 = p1 + b1[i];
            kc0[i] = (1.f - __expf(g0)) * __expf(r0 - bt0); kc1[i] = (1.f - __expf(g1)) * __expf(r1 - bt1);
            if (OUT) {
                const float q0 = bf_lo(qq[i]) * __expf(bt0 - r0), q1 = bf_hi(qq[i]) * __expf(bt1 - r1);
                const int t = 8 * w + i;
                *(LAS unsigned*)(lds + H_QT + t * 272 + c0 * 2) = pk2(q0, q1);
                *(LAS unsigned*)(lds + H_KC + t * 272 + c0 * 2) = pk2(kc0[i], kc1[i]);
            }
        }
        {
            u32x4 k0v = {pk2(kc0[0], kc0[1]), pk2(kc0[2], kc0[3]), pk2(kc0[4], kc0[5]), pk2(kc0[6], kc0[7])};
            u32x4 k1v = {pk2(kc1[0], kc1[1]), pk2(kc1[2], kc1[3]), pk2(kc1[4], kc1[5]), pk2(kc1[6], kc1[7])};
            *(LAS u32x4*)(lds + H_KCT + c0 * 144 + 16 * w) = k0v; *(LAS u32x4*)(lds + H_KCT + (c0 + 1) * 144 + 16 * w) = k1v;
            u32x4 v0v, v1v;
#pragma unroll
            for (int i = 0; i < 4; ++i) { v0v[i] = (vq[2 * i] & 0xffffu) | (vq[2 * i + 1] << 16); v1v[i] = (vq[2 * i] >> 16) | (vq[2 * i + 1] & 0xffff0000u); }
            *(LAS u32x4*)(lds + H_VT + c0 * 144 + 16 * w) = v0v; *(LAS u32x4*)(lds + H_VT + (c0 + 1) * 144 + 16 * w) = v1v;
        }
        LDS_WAIT(); __builtin_amdgcn_s_barrier(); asm volatile("" ::: "memory");
        if (ch + 1 < NCH) HG_LOAD(ch + 1);
        u32x4 gg0 = {0u, 0u, 0u, 0u}, gg1 = {0u, 0u, 0u, 0u};
        if (OUT) { const size_t grow = tok0 + (tid >> 3); gg0 = *(const u32x4*)(GH + grow * 1024 + h * 128 + 16 * (tid & 7)); gg1 = *(const u32x4*)(GH + grow * 1024 + h * 128 + 16 * (tid & 7) + 8); }
        f32x4 er[4];
#pragma unroll
        for (int jj = 0; jj < 4; ++jj) er[jj] = *(const LAS f32x4*)(ER + 32 * cb + 8 * jj + 4 * hh);
        asm volatile("" ::: "memory");
#pragma unroll
        for (int tl = 0; tl < 2; ++tl) {
#pragma unroll
            for (int e = 0; e < 16; ++e) S[tl][e] *= er[e >> 2][e & 3];
            if (OUT) {
#pragma unroll
                for (int jj = 0; jj < 4; ++jj) { u32x2 pw = {pk2(S[tl][4 * jj], S[tl][4 * jj + 1]), pk2(S[tl][4 * jj + 2], S[tl][4 * jj + 3])};
                    *(LAS u32x2*)(lds + H_SBT + (32 * (dvb0 + tl) + n) * 272 + (32 * cb + 8 * jj + 4 * hh) * 2) = pw; }
            }
        }
        if (OUT) {
            LDS_WAIT(); __builtin_amdgcn_s_barrier(); asm volatile("" ::: "memory");
            bf16x8 qf[8];
#pragma unroll
            for (int ks = 0; ks < 8; ++ks) qf[ks] = *(const LAS bf16x8*)(lds + H_QT + (32 * tbO + n) * 272 + (16 * ks + 8 * hh) * 2);
            f32x16 O, O2, O3;
#pragma unroll
            for (int e = 0; e < 16; ++e) { O[e] = 0.f; O2[e] = 0.f; O3[e] = 0.f; }
#pragma unroll
            for (int sb = 0; sb < 2; ++sb) {
                if (sb <= tbO) {
                    f32x16 P;
#pragma unroll
                    for (int e = 0; e < 16; ++e) P[e] = 0.f;
#pragma unroll
                    for (int ks = 0; ks < 8; ++ks) { const bf16x8 kf = *(const LAS bf16x8*)(lds + H_KC + (32 * sb + n) * 272 + (16 * ks + 8 * hh) * 2); P = MFMA32(kf, qf[ks], P); }
                    if (sb == tbO) {
#pragma unroll
                        for (int e = 0; e < 16; ++e) P[e] = (crow(e, hh) <= n) ? P[e] : 0.f;
                    }
#pragma unroll
                    for (int k2 = 0; k2 < 2; ++k2) {
                        u32x4 pp = {pk2(P[8 * k2], P[8 * k2 + 1]), pk2(P[8 * k2 + 2], P[8 * k2 + 3]), pk2(P[8 * k2 + 4], P[8 * k2 + 5]), pk2(P[8 * k2 + 6], P[8 * k2 + 7])};
                        const bf16x8 pa = __builtin_bit_cast(bf16x8, pp);
                        const LAS unsigned char* vp = lds + H_VT + (32 * dvbO + n) * 144 + (32 * sb + 16 * k2 + 4 * hh) * 2;
                        const s16x4 lo = *(const LAS s16x4*)vp, hi = *(const LAS s16x4*)(vp + 16);
                        const bf16x8 vb = __builtin_shufflevector(lo, hi, 0, 1, 2, 3, 4, 5, 6, 7);
                        O = MFMA32(pa, vb, O);
                    }
                }
            }
#pragma unroll
            for (int ks = 0; ks < 8; ++ks) { const bf16x8 sf = *(const LAS bf16x8*)(lds + H_SBT + (32 * dvbO + n) * 272 + (16 * ks + 8 * hh) * 2); if (ks & 1) O3 = MFMA32(qf[ks], sf, O3); else O2 = MFMA32(qf[ks], sf, O2); }
#pragma unroll
            for (int e = 0; e < 16; ++e) *(LAS float*)(lds + H_OST + (32 * tbO + crow(e, hh)) * 528 + (32 * dvbO + n) * 4) = O[e] + (O2[e] + O3[e]);
        }
#pragma unroll
        for (int ks = 0; ks < 4; ++ks) {
            const bf16x8 a = *(const LAS bf16x8*)(lds + H_KCT + (32 * cb + n) * 144 + (16 * ks + 8 * hh) * 2);
#pragma unroll
            for (int tl = 0; tl < 2; ++tl) { const bf16x8 bb = *(const LAS bf16x8*)(lds + H_VT + (32 * (dvb0 + tl) + n) * 144 + (16 * ks + 8 * hh) * 2); S[tl] = MFMA32(a, bb, S[tl]); }
        }
        {
            f32x4 er2[4];
#pragma unroll
            for (int jj = 0; jj < 4; ++jj) er2[jj] = *(const LAS f32x4*)(ER + 32 * cb + 8 * jj + 4 * hh);
#pragma unroll
            for (int tl = 0; tl < 2; ++tl)
#pragma unroll
                for (int e = 0; e < 16; ++e) S[tl][e] *= er2[e >> 2][e & 3];
        }
        if (OUT) {
            LDS_WAIT(); __builtin_amdgcn_s_barrier(); asm volatile("" ::: "memory");
            const int t = tid >> 3, cq = tid & 7;
            const size_t row = tok0 + t;
            const u32x4 g0 = gg0, g1 = gg1;
            f32x4 o[4]; float sq = 0.f;
#pragma unroll
            for (int i = 0; i < 4; ++i) { o[i] = *(const LAS f32x4*)(lds + H_OST + t * 528 + (16 * cq + 4 * i) * 4); sq += (o[i][0] * o[i][0] + o[i][1] * o[i][1]) + (o[i][2] * o[i][2] + o[i][3] * o[i][3]); }
            sq += shx<1>(sq); sq += shx<2>(sq); sq += shx<4>(sq);
            const float rs = rsqrtf(sq * (1.f / 128.f) + EPS);
            float r[16];
#pragma unroll
            for (int i = 0; i < 4; ++i) { const f32x4 wv = *(const LAS f32x4*)(lds + H_HGW + (16 * cq + 4 * i) * 4);
#pragma unroll
                for (int e = 0; e < 4; ++e) r[4 * i + e] = o[i][e] * rs * wv[e]; }
            u32x4 w0, w1;
#pragma unroll
            for (int i = 0; i < 4; ++i) { w0[i] = pk2(r[2 * i] * bf_lo(g0[i]), r[2 * i + 1] * bf_hi(g0[i])); w1[i] = pk2(r[8 + 2 * i] * bf_lo(g1[i]), r[8 + 2 * i + 1] * bf_hi(g1[i])); }
            bf16_t* op = QA + row * 2048 + h * 128 + 16 * cq;
            *(u32x4*)op = w0; *(u32x4*)(op + 8) = w1;
        }
    }
    if (!OUT) {
        unsigned* Lp = (unsigned*)ST + (size_t)unit * 8192 + (size_t)(w * 16) * 64 + lane;
#pragma unroll
        for (int tl = 0; tl < 2; ++tl)
#pragma unroll
            for (int e = 0; e < 8; ++e) Lp[(tl * 8 + e) * 64] = pk2(S[tl][2 * e], S[tl][2 * e + 1]);
        if (w == 0) *(f32x2*)(HD + (size_t)unit * 128 + c0) = (f32x2){__expf(dlog0), __expf(dlog1)};
    }
    LDS_WAIT(); __builtin_amdgcn_s_barrier(); asm volatile("" ::: "memory");
}

constexpr int A_KS = 0, A_VT = 36864;
__device__ __forceinline__ void attn_phase(LAS unsigned char* lds, unsigned* qctr, bf16_t* QA, const bf16_t* AK, const bf16_t* AV, const float* sinks  ) {
    const int tid = fresh_tid(), w = __builtin_amdgcn_readfirstlane(tid >> 6), lane = tid & 63, n = lane & 31, hh = lane >> 5;
    constexpr int NU = BATCH * 128 * 4;
    constexpr float L2E = 1.4426950408889634f;
    const int g = w >> 1;
    volatile LAS unsigned* qw = (volatile LAS unsigned*)(lds + LDS_XB + 128);
    if (tid == 0) qw[0] = __hip_atomic_fetch_add(qctr, 1u, __ATOMIC_RELAXED, __HIP_MEMORY_SCOPE_AGENT);
    __syncthreads();
    int unit = (int)qw[0];
    __syncthreads();
    if (unit >= NU) return;
    u32x4 kr[4], vr[4]; bf16x8 qn[4];
#pragma unroll
    for (int i = 0; i < 4; ++i) { kr[i] = (u32x4){0u, 0u, 0u, 0u}; vr[i] = (u32x4){0u, 0u, 0u, 0u}; }
#define AT_LOADKV(un_) do { const int kvh_ = (un_) & 3, blk_ = ((un_) >> 2) & 127, b_ = (un_) >> 9; const long tb_ = (long)b_ * SEQ + (long)blk_ * 128; const int k0_ = (blk_ == 0) ? 128 : 0; \
        _Pragma("unroll") for (int i = 0; i < 4; ++i) { const int ci = tid + 512 * i; { const int key = ci >> 3, part = ci & 7; if (key >= k0_) kr[i] = *(const u32x4*)(AK + (size_t)(tb_ - 128 + key) * 256 + kvh_ * 64 + part * 8); } \
            { const int key = ci >> 3, part = ci & 7; if (key >= k0_) vr[i] = *(const u32x4*)(AV + (size_t)(tb_ - 128 + key) * 256 + kvh_ * 64 + part * 8); } } } while (0)
#define AT_QROW(un_, qs_) (QA + (size_t)((long)((un_) >> 9) * SEQ + (long)(((un_) >> 2) & 127) * 128 + 32 * (qs_) + n) * 2048 + 1024 + (((un_) & 3) * 4 + g) * 64)
#define AT_LOADQ(un_, qs_) do { const bf16_t* qr_ = AT_QROW(un_, qs_); _Pragma("unroll") for (int ks = 0; ks < 4; ++ks) qn[ks] = *(const bf16x8*)(qr_ + 16 * ks + 8 * hh); } while (0)
    AT_LOADKV(unit); AT_LOADQ(unit, 2 * (w & 1));
    float sinkn = sinks[(unit & 3) * 4 + g];
#pragma unroll 1
    for (;;) {
        const int kvh = unit & 3, blk = (unit >> 2) & 127;
        if (tid == 0) qw[0] = __hip_atomic_fetch_add(qctr, 1u, __ATOMIC_RELAXED, __HIP_MEMORY_SCOPE_AGENT);
        const int kk0 = (blk == 0) ? 128 : 0;
#pragma unroll
        for (int i = 0; i < 4; ++i) {
            const int ci = tid + 512 * i;
            { const int key = ci >> 3, part = ci & 7; if (key >= kk0) *(LAS u32x4*)(lds + A_KS + key * 144 + part * 16) = kr[i]; }
            { const int key = ci >> 3, part = ci & 7, ksw = key ^ (part << 2); if (key >= kk0) {
#pragma unroll
                for (int e = 0; e < 4; ++e) { *(LAS unsigned short*)(lds + A_VT + (part * 8 + 2 * e) * 528 + ksw * 2) = (unsigned short)(vr[i][e] & 0xffffu); *(LAS unsigned short*)(lds + A_VT + (part * 8 + 2 * e + 1) * 528 + ksw * 2) = (unsigned short)(vr[i][e] >> 16); } } }
        }
        LDS_WAIT(); __builtin_amdgcn_s_barrier(); asm volatile("" ::: "memory");
        const int un = (int)qw[0];
        const float sink = sinkn;
        if (un < NU) { AT_LOADKV(un); sinkn = sinks[(un & 3) * 4 + g]; }
        const int hq = kvh * 4 + g;
#pragma unroll 1
        for (int tk = 0; tk < 2; ++tk) {
            const int qs = 2 * (w & 1) + tk;
            bf16_t* qrow = AT_QROW(unit, qs);
            bf16x8 qf[4];
#pragma unroll
            for (int ks = 0; ks < 4; ++ks) qf[ks] = qn[ks];
            if (tk == 0) AT_LOADQ(unit, qs + 1); else if (un < NU) AT_LOADQ(un, 2 * (w & 1));
            f32x16 P[5];
#pragma unroll
            for (int jt = 0; jt < 5; ++jt) {
                const bool tv = !(blk == 0 && qs + jt < 4);
#pragma unroll
                for (int e = 0; e < 16; ++e) P[jt][e] = 0.f;
                if (tv) {
#pragma unroll
                    for (int ks = 0; ks < 4; ++ks) { const bf16x8 kf = *(const LAS bf16x8*)(lds + A_KS + (32 * qs + 32 * jt + n) * 144 + (16 * ks + 8 * hh) * 2); P[jt] = MFMA32(kf, qf[ks], P[jt]); }
                }
#pragma unroll
                for (int e = 0; e < 16; ++e) {
                    bool ok = tv;
                    if (jt == 0) ok = ok && (crow(e, hh) > n);
                    if (jt == 4) ok = ok && (crow(e, hh) <= n);
                    P[jt][e] = ok ? P[jt][e] : -INFINITY;
                }
            }
            float mx = sink;
#pragma unroll
            for (int jt = 0; jt < 5; ++jt)
#pragma unroll
                for (int e = 0; e < 16; ++e) mx = fmaxf(mx, P[jt][e]);
            mx = fmaxf(mx, shx<32>(mx));
            float sum = 0.f;
#pragma unroll
            for (int jt = 0; jt < 5; ++jt)
#pragma unroll
                for (int e = 0; e < 16; ++e) { const float p = __builtin_amdgcn_exp2f((P[jt][e] - mx) * L2E); P[jt][e] = p; sum += p; }
            sum += shx<32>(sum);
            const float inv = rcpf(sum + __builtin_amdgcn_exp2f((sink - mx) * L2E));
            f32x16 O[2];
#pragma unroll
            for (int e = 0; e < 16; ++e) { O[0][e] = 0.f; O[1][e] = 0.f; }
#pragma unroll
            for (int jt = 0; jt < 5; ++jt) {
                const bool tv = !(blk == 0 && qs + jt < 4);
                if (tv) {
#pragma unroll
                    for (int k2 = 0; k2 < 2; ++k2) {
                        u32x4 pp = {pk2(P[jt][8 * k2], P[jt][8 * k2 + 1]), pk2(P[jt][8 * k2 + 2], P[jt][8 * k2 + 3]), pk2(P[jt][8 * k2 + 4], P[jt][8 * k2 + 5]), pk2(P[jt][8 * k2 + 6], P[jt][8 * k2 + 7])};
                        const bf16x8 pb = __builtin_bit_cast(bf16x8, pp);
#pragma unroll
                        for (int dvb = 0; dvb < 2; ++dvb) {
                            const int dvr = 32 * dvb + n, kx = 32 * qs + 32 * jt + 16 * k2 + 4 * hh, sw = (dvr >> 3) << 2;
                            const LAS unsigned char* vrow = lds + A_VT + dvr * 528;
                            const s16x4 lo = *(const LAS s16x4*)(vrow + ((kx ^ sw) * 2)), hi = *(const LAS s16x4*)(vrow + (((kx + 8) ^ sw) * 2));
                            const bf16x8 va = __builtin_shufflevector(lo, hi, 0, 1, 2, 3, 4, 5, 6, 7);
                            O[dvb] = MFMA32(va, pb, O[dvb]);
                        }
                    }
                }
            }
#pragma unroll
            for (int dvb = 0; dvb < 2; ++dvb)
#pragma unroll
                for (int jj = 0; jj < 4; ++jj) {
                    u32x2 ow = {pk2(O[dvb][4 * jj] * inv, O[dvb][4 * jj + 1] * inv), pk2(O[dvb][4 * jj + 2] * inv, O[dvb][4 * jj + 3] * inv)};
                    *(u32x2*)(qrow + 32 * dvb + 8 * jj + 4 * hh) = ow;
                }
        }
        LDS_WAIT(); __builtin_amdgcn_s_barrier(); asm volatile("" ::: "memory");
        if (un >= NU) break;
        unit = un;
    }
#undef AT_LOADKV
#undef AT_QROW
#undef AT_LOADQ
}

#define XB_TMO      128
#define XB_XCNT(j)  (256  + 64 * (j))
#define XB_XSUB(j)  (1280 + 64 * (j))
#define XB_XGEN(j)  (2304 + 64 * (j))
#define XB_TOP      3328
#define XB_TOPGEN   3392
#define XCD_BAR_WORDS 3456
#define XB_SPIN_CAP (1u << 18)

__device__ __forceinline__ unsigned xb_ld(unsigned* p)              { return __hip_atomic_load(p, __ATOMIC_RELAXED, __HIP_MEMORY_SCOPE_AGENT); }
__device__ __forceinline__ unsigned xb_add(unsigned* p, unsigned v) { return __hip_atomic_fetch_add(p, v, __ATOMIC_RELAXED, __HIP_MEMORY_SCOPE_AGENT); }
__device__ __forceinline__ unsigned xb_xcc_id() { return (unsigned)__builtin_amdgcn_s_getreg((3 << 11) | 20) & 0xFu; }
#define XB_SPIN(cond, bar) do { unsigned _sp = 0; while (cond) { __builtin_amdgcn_s_sleep(1); \
    if ((++_sp & 255u) == 0u) { if (xb_ld(&(bar)[XB_TMO])) break; if (_sp > XB_SPIN_CAP) { atomicAdd(&(bar)[XB_TMO], 1u); break; } } } } while (0)

struct XcdBarrier {
    unsigned* bar; unsigned x;
    volatile LAS unsigned* st;
};

__device__ __forceinline__ XcdBarrier xcd_barrier_post(unsigned* bar, volatile LAS unsigned* st) {
    XcdBarrier b; b.bar = bar; b.x = xb_xcc_id(); b.st = st;
    if (threadIdx.x == 0) (void)xb_add(&bar[XB_XCNT(b.x)], 1u);
    return b;
}
__device__ __forceinline__ void xcd_barrier_complete(unsigned* bar, unsigned x, unsigned& nloc, unsigned& nx) {
    const unsigned G = gridDim.x * gridDim.y * gridDim.z;
    unsigned sum, cnt, mine, sp = 0u;
    for (;;) {
        sum = 0u; cnt = 0u; mine = 0u;
#pragma unroll
        for (unsigned j = 0; j < 16; ++j) { const unsigned c = xb_ld(&bar[XB_XCNT(j)]); sum += c; cnt += (c > 0u) ? 1u : 0u; mine = (j == x) ? c : mine; }
        if (sum == G) break;
        __builtin_amdgcn_s_sleep(1);
        if ((++sp & 255u) == 0u) { if (xb_ld(&bar[XB_TMO])) break; if (sp > XB_SPIN_CAP) { atomicAdd(&bar[XB_TMO], 1u); break; } }
    }
    nloc = mine > 0u ? mine : 1u; nx = cnt > 0u ? cnt : 1u;
}

__device__ __forceinline__ void xcd_barrier(const XcdBarrier& b) {
    asm volatile("s_waitcnt vmcnt(0)" ::: "memory");
    __syncthreads();
    if (threadIdx.x == 0) {
        unsigned* bar = b.bar;
        __builtin_amdgcn_s_waitcnt(0);
        unsigned nloc = b.st[0], nx = b.st[1];
        if (nloc == 0u) { xcd_barrier_complete(bar, b.x, nloc, nx); b.st[0] = nloc; b.st[1] = nx; }
        const unsigned old = xb_add(&bar[XB_XSUB(b.x)], 1u);
        const unsigned gen = old / nloc;
        if (old + 1u == (gen + 1u) * nloc) {
            __builtin_amdgcn_fence(__ATOMIC_RELEASE, "agent");
            asm volatile("s_waitcnt vmcnt(0)" ::: "memory");
            const unsigned og = xb_add(&bar[XB_TOP], 1u);
            const unsigned tg = og / nx;
            if (og + 1u == (tg + 1u) * nx) xb_add(&bar[XB_TOPGEN], 1u);
            else XB_SPIN(xb_ld(&bar[XB_TOPGEN]) == tg, bar);
            __builtin_amdgcn_fence(__ATOMIC_ACQUIRE, "agent");
            xb_add(&bar[XB_XGEN(b.x)], 1u);
            asm volatile("s_waitcnt vmcnt(0)" ::: "memory");
        } else {
            XB_SPIN(xb_ld(&bar[XB_XGEN(b.x)]) == gen, bar);
            __builtin_amdgcn_fence(__ATOMIC_ACQUIRE, "agent");
            asm volatile("s_waitcnt vmcnt(0)" ::: "memory");
        }
    }
    __syncthreads();
}

__device__ __forceinline__ float rstd_of(const float* p) {
    const f32x4 a = *(const f32x4*)p, b = *(const f32x4*)(p + 4), c = *(const f32x4*)(p + 8), d = *(const f32x4*)(p + 12);
    const float s = (((a[0] + a[1]) + (a[2] + a[3])) + ((b[0] + b[1]) + (b[2] + b[3]))) + (((c[0] + c[1]) + (c[2] + c[3])) + ((d[0] + d[1]) + (d[2] + d[3])));
    return rsqrtf(s * (1.f / D) + EPS);
}
__device__ __forceinline__ void compute_rstd(LAS unsigned char* lds, const pg8::StaticOrder& S, const float* ssp) {
    const int tid = fresh_tid(), r = tid & 255, half = tid >> 8;
    LAS float* RS = (LAS float*)(lds + LDS_RS);
    f32x4 p[8][4]; bool ok[8];
#pragma unroll
    for (int k = 0; k < 8; ++k) {
        pg8::Unit u; ok[k] = S.next(2 * k + half, u);
        const float* q = ssp + (size_t)((ok[k] ? u.pm : 0) * 256 + r) * 16;
#pragma unroll
        for (int e = 0; e < 4; ++e) p[k][e] = ok[k] ? *(const f32x4*)(q + 4 * e) : (f32x4){0.f, 0.f, 0.f, 0.f};
    }
#pragma unroll
    for (int k = 0; k < 8; ++k) {
        const f32x4 a = p[k][0], b = p[k][1], c = p[k][2], d = p[k][3];
        const float s = (((a[0] + a[1]) + (a[2] + a[3])) + ((b[0] + b[1]) + (b[2] + b[3]))) + (((c[0] + c[1]) + (c[2] + c[3])) + ((d[0] + d[1]) + (d[2] + d[3])));
        if (ok[k]) RS[(2 * k + half) * 256 + r] = rsqrtf(s * (1.f / D) + EPS);
    }
    __syncthreads();
}
struct Args { const float* in[14]; float* out; unsigned char* ws; };

__global__ void __launch_bounds__(NTHR, 2) hybrid_fwd(Args args) {
    extern __shared__ __attribute__((aligned(16))) unsigned char lds_raw[];
    LAS unsigned char* lds = (LAS unsigned char*)lds_raw;
    cg::grid_group grid = cg::this_grid();
#define GRID_SYNC() xcd_barrier(xbar)
#define CG_SYNC() do { asm volatile("s_waitcnt vmcnt(0)" ::: "memory"); grid.sync(); } while (0)
    const int G = gridDim.x, bx = blockIdx.x, NGW = G * NWAVES;
#define FRESH_IDS const int tid = fresh_tid(), lane = tid & 63, wave = __builtin_amdgcn_readfirstlane(tid >> 6), gw = bx * NWAVES + wave; LAS float* scr = (LAS float*)(lds + wave * 16384); (void)tid; (void)lane; (void)gw; (void)scr
    unsigned char* ws = args.ws;
    const float* x_in = args.in[0]; const float* norm1 = args.in[1]; const float* w_in = args.in[2]; const float* lb_logits = args.in[3];
    const float* hg_norm = args.in[4]; const float* attn_sinks = args.in[5]; const float* w_pa = args.in[6]; const float* w_pb = args.in[7];
    const float* w_o = args.in[8]; const float* norm2 = args.in[9]; const float* w_gate = args.in[10]; const float* w_up = args.in[11];
    const float* w_down = args.in[12]; const float* final_norm = args.in[13];
    float* X = args.out;
    float* SSP = (float*)(ws + WS_SSP); float* LB = (float*)(ws + WS_LB); float* HD = (float*)(ws + WS_HD); float* ROPE = (float*)(ws + WS_ROPE);
    bf16_t* WIN = (bf16_t*)(ws + WS_WIN); bf16_t* WPA = (bf16_t*)(ws + WS_WPA); bf16_t* WPB = (bf16_t*)(ws + WS_WPB); bf16_t* WO = (bf16_t*)(ws + WS_WO);
    bf16_t* WGU = (bf16_t*)(ws + WS_WGU); bf16_t* WD = (bf16_t*)(ws + WS_WD);
    bf16_t* XB = (bf16_t*)(ws + WS_XB); bf16_t* QA = (bf16_t*)(ws + WS_QA); _Float16* LOGF = (_Float16*)(ws + WS_LOGF); bf16_t* VH = (bf16_t*)(ws + WS_V);
    bf16_t* GH = (bf16_t*)(ws + WS_GH); bf16_t* AK = (bf16_t*)(ws + WS_AK); bf16_t* AV = (bf16_t*)(ws + WS_AV); float* ST = (float*)(ws + WS_ST);
    unsigned* QCTR = (unsigned*)(ws + WS_BAR) + 3584;
    bf16_t* GATE = (bf16_t*)(ws + WS_GATE); bf16_t* GATEB = (bf16_t*)(ws + WS_LOGF); bf16_t* MIX = (bf16_t*)(ws + WS_MIX); bf16_t* ACT = (bf16_t*)(ws + WS_ACT);

    {
        FRESH_IDS;
        const int gt = bx * NTHR + tid, NGT = G * NTHR;
        { if (gt < 16) QCTR[gt] = 0u; for (int i = gt; i < XCD_BAR_WORDS; i += NGT) ((unsigned*)(ws + WS_BAR))[i] = 0u; if (tid < 64) ((LAS unsigned*)(lds + LDS_XB))[tid] = 0u; }
        for (int i = gt; i < 1024; i += NGT) {
            float l[4], mx = -INFINITY, s = 0.f;
#pragma unroll
            for (int k = 0; k < 4; ++k) { l[k] = lb_logits[k * 1024 + i]; mx = fmaxf(mx, l[k]); }
#pragma unroll
            for (int k = 0; k < 4; ++k) { l[k] = expf(l[k] - mx); s += l[k]; }
            float c = 0.f; const float p0 = l[0] / s;
#pragma unroll
            for (int k = 0; k < 4; ++k) { c += l[k] / s; LB[k * 1024 + i] = c - p0; }
        }
        for (int i = gt; i < SEQ * 8; i += NGT) {
            const int pos = i >> 3, k = i & 7;
            const float inv = (float)exp2(-(double)k * 0.125 * 18.931568569324174);
            const float ang = (float)pos * inv;
            const double a = (double)ang; const double kq = rint(a * 0.15915494309189535); const double r = a - kq * 6.283185307179586;
            ROPE[pos * 16 + k] = cosf((float)r); ROPE[pos * 16 + 8 + k] = sinf((float)r);
        }
        int ioff = 0;
        convert_matrix(w_in, D, NIN, norm1, WIN, 0, scr, gw, NGW, lane, ioff);
        convert_matrix(w_pa, D, D, nullptr, WPA, 0, scr, gw, NGW, lane, ioff, 2 * D);
        convert_matrix(w_pb, D, D, nullptr, WPA + D, 0, scr, gw, NGW, lane, ioff, 2 * D);
        convert_matrix(w_o, D, D, nullptr, WO, 0, scr, gw, NGW, lane, ioff);
        convert_matrix(w_gate, D, FF, norm2, WGU, 1, scr, gw, NGW, lane, ioff);
        convert_matrix(w_up, D, FF, norm2, WGU, 2, scr, gw, NGW, lane, ioff);
        convert_matrix(w_down, FF, D, nullptr, WD, 0, scr, gw, NGW, lane, ioff);
        for (int m0 = gw; m0 < T; m0 += 4 * NGW) {
            f32x4 v[4][4];
#pragma unroll
            for (int r = 0; r < 4; ++r)
#pragma unroll
                for (int j = 0; j < 4; ++j) v[r][j] = (m0 + r * NGW < T) ? ((const f32x4*)(x_in + (size_t)(m0 + r * NGW) * D) + lane)[64 * j] : (f32x4){0.f, 0.f, 0.f, 0.f};
#pragma unroll
            for (int r = 0; r < 4; ++r) {
                const int m = m0 + r * NGW; float s = 0.f;
                if (m >= T) break;
                unsigned long long* o8 = (unsigned long long*)(XB + (size_t)m * D) + lane;
#pragma unroll
                for (int j = 0; j < 4; ++j) { const f32x4 q = v[r][j]; s += (q.x * q.x + q.y * q.y) + (q.z * q.z + q.w * q.w); o8[64 * j] = (unsigned long long)pk2(q.x, q.y) | ((unsigned long long)pk2(q.z, q.w) << 32); }
                s = wave_sum(s);
                if (lane < 16) SSP[(size_t)m * 16 + lane] = (lane == 0) ? s : 0.f;
            }
        }
    }
    CG_SYNC();
    const XcdBarrier xbar = xcd_barrier_post((unsigned*)(ws + WS_BAR), (volatile LAS unsigned*)(lds + LDS_XB));

#pragma unroll 1
    for (int l = 0; l < DEPTH; ++l) {
        const float* ss1 = SSP + (size_t)(2 * l) * T * 16; float* ss2 = SSP + (size_t)(2 * l + 1) * T * 16; float* ss3 = SSP + (size_t)(2 * l + 2) * T * 16;
        const LAS float* RS = (const LAS float*)(lds + LDS_RS);
        {
            FRESH_IDS;
            if (l > 0) {
                int ioff = 0;
                convert_matrix(w_down + (size_t)l * FF * D, FF, D, nullptr, WD, 0, scr, gw, NGW, lane, ioff);
                convert_matrix(w_pa + (size_t)l * D * D, D, D, nullptr, WPA, 0, scr, gw, NGW, lane, ioff, 2 * D);
                convert_matrix(w_pb + (size_t)l * D * D, D, D, nullptr, WPA + D, 0, scr, gw, NGW, lane, ioff, 2 * D);
                convert_matrix(w_o + (size_t)l * D * D, D, D, nullptr, WO, 0, scr, gw, NGW, lane, ioff);
            }
            pg8::Gemm g{XB, WIN, T, NIN1, D, D}; pg8::StaticOrder S; S.init(T, NIN1, G, bx);
            compute_rstd(lds, S, ss1);
            EpiG1 E{RS, LB + l * 1024, ROPE, QA, LOGF, VH, GH, AK, AV};
            pg8::gemm_phase<EpiG1>(lds, g, S, E);
        }
        GRID_SYNC();
        {
            for (int u = bx; u < BATCH * HGH * NSC; u += G) if ((u % NSC) != NSC - 1) hgrn_unit<false>(lds, u, LOGF, QA, VH, GH, hg_norm + l * 1024, ST, HD);
        }
        GRID_SYNC();
        {
            for (int u = bx; u < BATCH * HGH * NSC; u += G) hgrn_unit<true>(lds, u, LOGF, QA, VH, GH, hg_norm + l * 1024, ST, HD);
            attn_phase(lds, QCTR + l, QA, AK, AV, attn_sinks + l * 16);
        }
        GRID_SYNC();
        {
            pg8::StaticOrder S; S.init(T, D, G, bx);
            compute_rstd(lds, S, ss1);
            {
            { pg8::StaticOrder S2 = S; S2.PAIR = true; pg8::Gemm g{XB, WIN + (size_t)NIN1 * D, T, 2 * D, D, D}; EpiGate E{RS, GATE, GATEB}; pg8::gemm_phase<EpiGate>(lds, g, S2, E); }
            { pg8::Gemm g{QA, WPA, T, D, 2 * D, 2 * D}; EpiMixK E{GATE, GATEB, MIX}; pg8::gemm_phase<EpiMixK>(lds, g, S, E); }
            }
        }
        GRID_SYNC();
        {
            pg8::Gemm g{MIX, WO, T, D, D, D}; pg8::StaticOrder S; S.init(T, D, G, bx);
            EpiRes E{XB, ss2};
            pg8::gemm_phase<EpiRes>(lds, g, S, E);
        }
        GRID_SYNC();
        {
            FRESH_IDS;
            if (l + 1 < DEPTH) {
                int ioff = 0;
                convert_matrix(w_in + (size_t)(l + 1) * D * NIN, D, NIN, norm1 + (l + 1) * D, WIN, 0, scr, gw, NGW, lane, ioff);
            }
            pg8::Gemm g{XB, WGU, T, NGU, D, D}; pg8::StaticOrder S; S.init(T, NGU, G, bx);
            compute_rstd(lds, S, ss2);
            EpiSwiglu E{RS, ACT};
            pg8::gemm_phase<EpiSwiglu>(lds, g, S, E);
        }
        GRID_SYNC();
        {
            FRESH_IDS;
            if (l + 1 < DEPTH) {
                int ioff = 0;
                convert_matrix(w_gate + (size_t)(l + 1) * D * FF, D, FF, norm2 + (l + 1) * D, WGU, 1, scr, gw, NGW, lane, ioff);
                convert_matrix(w_up + (size_t)(l + 1) * D * FF, D, FF, norm2 + (l + 1) * D, WGU, 2, scr, gw, NGW, lane, ioff);
            }
            __syncthreads();
            pg8::Gemm g{ACT, WD, T, D, FF, FF}; pg8::StaticOrder S; S.init(T, D, G, bx);
            EpiRes E{XB, ss3};
            pg8::gemm_phase<EpiRes>(lds, g, S, E);
        }
        GRID_SYNC();
    }
    {
        FRESH_IDS;
        const float* ssf = SSP + (size_t)8 * T * 16;
        f32x4 g4[4];
#pragma unroll
        for (int j = 0; j < 4; ++j) g4[j] = ((const f32x4*)final_norm + lane)[64 * j];
        for (int m0 = gw; m0 < T; m0 += 4 * NGW) {
            u32x2 v[4][4]; float rstd[4];
#pragma unroll
            for (int r = 0; r < 4; ++r) { const int m = m0 + r * NGW; const bool ok = m < T;
                rstd[r] = ok ? rstd_of(ssf + (size_t)m * 16) : 0.f;
#pragma unroll
                for (int j = 0; j < 4; ++j) v[r][j] = ok ? ((const u32x2*)(XB + (size_t)m * D) + lane)[64 * j] : (u32x2){0u, 0u}; }
#pragma unroll
            for (int r = 0; r < 4; ++r) { const int m = m0 + r * NGW; if (m >= T) break;
                f32x4* orow = (f32x4*)(X + (size_t)m * D) + lane;
#pragma unroll
                for (int j = 0; j < 4; ++j) orow[64 * j] = (f32x4){bf_lo(v[r][j].x), bf_hi(v[r][j].x), bf_lo(v[r][j].y), bf_hi(v[r][j].y)} * rstd[r] * g4[j]; }
        }
    }
}

extern "C" void kernel_launch(void* const* d_in, const int* in_sizes, int n_in, void* d_out, int out_size, void* d_ws, size_t ws_size, hipStream_t stream) {
    static int grid = 0;
    if (grid == 0) {
        if (n_in != 14 || out_size != T * D || ws_size < WS_END) { fprintf(stderr, "kernel_launch: unexpected shapes (n_in %d out %d ws %zu)\n", n_in, out_size, ws_size); grid = -1; return; }
        int dev = 0, cus = 0, per_cu = 0;
        hipGetDevice(&dev);
        hipDeviceGetAttribute(&cus, hipDeviceAttributeMultiprocessorCount, dev);
        if (hipFuncSetAttribute((const void*)hybrid_fwd, hipFuncAttributeMaxDynamicSharedMemorySize, LDS_BYTES) != hipSuccess) { fprintf(stderr, "kernel_launch: hipFuncSetAttribute failed\n"); grid = -1; return; }
        if (hipOccupancyMaxActiveBlocksPerMultiprocessor(&per_cu, (const void*)hybrid_fwd, NTHR, LDS_BYTES) != hipSuccess || per_cu < 1) { fprintf(stderr, "kernel_launch: occupancy query gave %d\n", per_cu); per_cu = 1; }
        (void)hipGetLastError();
        grid = cus * 1;
        if (grid > 256) grid = 256;
    }
    if (grid < 0) return;
    Args a{};
    for (int i = 0; i < 14; ++i) a.in[i] = (const float*)d_in[i];
    a.out = (float*)d_out; a.ws = (unsigned char*)d_ws;
    void* kargs[] = {&a};
    hipError_t e = hipLaunchCooperativeKernel((const void*)hybrid_fwd, dim3(grid), dim3(NTHR), kargs, LDS_BYTES, stream);
    if (e != hipSuccess) fprintf(stderr, "kernel_launch: cooperative launch failed: %s (grid %d)\n", hipGetErrorString(e), grid);
}
```
